# Optimizing an MI355X kernel written in HIP

```python
import math, functools
import jax, jax.numpy as jnp
from jax import lax
import numpy as np

D_MODEL = 1024
BATCH = 8
SEQ = 2048
DEPTH = 4

N_MIXERS = 3
POOL_WINDOWS = (2, 4, 8, 16)
POOL_GROUPS = len(POOL_WINDOWS)
POOL_GROUP_DIM = D_MODEL // POOL_GROUPS
ATTN_PATTERNS = ((128, 1), (512, 4), (2048, 16))
ATTN_GROUPS = len(ATTN_PATTERNS)
HEAD_DIM = 64
HEADS_PER_GROUP = D_MODEL // HEAD_DIM
ATTN_INNER = HEADS_PER_GROUP * HEAD_DIM
ROT_DIM = HEAD_DIM // 4
ROPE_THETA = 500000.0
CONV_WIDTH = 3
D_FF = 2816
N_EXPERTS = 8
TOP_K = 2
D_FF_EXPERT = 3584
DN_ALPHA = (2 * DEPTH) ** 0.25
DN_BETA = (8 * DEPTH) ** -0.25
LN_EPS = 1e-5

kernel_name = "hybrid_pool_dilattn_shortconv_moe_deepnorm"


def layer_norm(x, g, b):
    xf = x.astype(jnp.float32)
    mu = jnp.mean(xf, axis=-1, keepdims=True)
    var = jnp.mean(jnp.square(xf - mu), axis=-1, keepdims=True)
    y = (xf - mu) * lax.rsqrt(var + LN_EPS) * g.astype(jnp.float32) + b.astype(jnp.float32)
    return y.astype(x.dtype)


def causal_mean_minus_self(u, window):
    S = u.shape[1]
    c = jnp.cumsum(u.astype(jnp.float32), axis=1)
    c = jnp.pad(c, ((0, 0), (1, 0), (0, 0)))
    t = jnp.arange(S)
    lo = jnp.maximum(t + 1 - window, 0)
    total = c[:, 1:] - c[:, lo]
    cnt = jnp.minimum(t + 1, window).astype(jnp.float32)[None, :, None]
    return (total / cnt - u.astype(jnp.float32)).astype(u.dtype)


def pool_mixer(x, w_in, w_grp, scale):
    B, S, _ = x.shape
    u = (x @ w_in).reshape(B, S, POOL_GROUPS, POOL_GROUP_DIM)
    pooled = jnp.stack([causal_mean_minus_self(u[:, :, g], w) for g, w in enumerate(POOL_WINDOWS)], axis=2)
    y = jnp.einsum('bsgc,gcd->bsgd', pooled, w_grp).reshape(B, S, D_MODEL)
    return y * scale


def rope_tables(positions):
    inv_freq = ROPE_THETA ** (-(jnp.arange(0, ROT_DIM, 2, dtype=jnp.float32) / ROT_DIM))
    ang = positions.astype(jnp.float32)[..., None] * inv_freq
    return jnp.cos(ang), jnp.sin(ang)


def apply_partial_rope(t, cos, sin):
    half = ROT_DIM // 2
    c = cos[:, :, None, :].astype(t.dtype)
    s = sin[:, :, None, :].astype(t.dtype)
    r1, r2, rest = t[..., :half], t[..., half:ROT_DIM], t[..., ROT_DIM:]
    return jnp.concatenate([r1 * c - r2 * s, r1 * s + r2 * c, rest], axis=-1)


def dilated_window_attention(q, k, v, window, dilation):
    B, S, H, Dh = q.shape
    L = S // dilation
    nk = window // dilation
    blk = nk
    nb = -(-L // blk)
    Lp = nb * blk

    def to_blocks(t):
        t = t.reshape(B, L, dilation, H, Dh).transpose(0, 2, 1, 3, 4)
        t = jnp.pad(t, ((0, 0), (0, 0), (0, Lp - L), (0, 0), (0, 0)))
        return t.reshape(B, dilation, nb, blk, H, Dh)

    def with_prev(t):
        prev = jnp.pad(t, ((0, 0), (0, 0), (1, 0), (0, 0), (0, 0), (0, 0)))[:, :, :-1]
        return jnp.concatenate([prev, t], axis=3)

    qb = to_blocks(q)
    kk = with_prev(to_blocks(k))
    vv = with_prev(to_blocks(v))
    scores = jnp.einsum('brnqhd,brnkhd->brnhqk', qb, kk).astype(jnp.float32) * (Dh ** -0.5)
    qi = jnp.arange(nb)[:, None] * blk + jnp.arange(blk)[None, :]
    ki = jnp.arange(nb)[:, None] * blk - blk + jnp.arange(2 * blk)[None, :]
    rel = qi[:, :, None] - ki[:, None, :]
    valid = (rel >= 0) & (rel <= nk) & (ki[:, None, :] >= 0)
    scores = jnp.where(valid[None, None, :, None], scores, -jnp.inf)
    lse = jax.nn.logsumexp(scores, axis=-1)
    p = jnp.exp(scores - lse[..., None])
    out = jnp.einsum('brnhqk,brnkhd->brnqhd', p.astype(v.dtype), vv)
    out = out.reshape(B, dilation, Lp, H, Dh)[:, :, :L].transpose(0, 2, 1, 3, 4).reshape(B, S, H, Dh)
    lse = lse.transpose(0, 1, 2, 4, 3).reshape(B, dilation, Lp, H)[:, :, :L]
    lse = lse.transpose(0, 2, 1, 3).reshape(B, S, H)
    return out, lse


def dilated_attention_mixer(x, cos, sin, w_qkv, w_o):
    B, S, _ = x.shape
    qkv = (x @ w_qkv).reshape(B, S, ATTN_GROUPS, 3, HEADS_PER_GROUP, HEAD_DIM)
    outs, lses = [], []
    for g, (win, dil) in enumerate(ATTN_PATTERNS):
        q = apply_partial_rope(qkv[:, :, g, 0], cos, sin)
        k = apply_partial_rope(qkv[:, :, g, 1], cos, sin)
        o, l = dilated_window_attention(q, k, qkv[:, :, g, 2], win, dil)
        outs.append(o.astype(jnp.float32))
        lses.append(l)
    wts = jax.nn.softmax(jnp.stack(lses, axis=0), axis=0)
    o = jnp.sum(wts[..., None] * jnp.stack(outs, axis=0), axis=0)
    return o.reshape(B, S, ATTN_INNER).astype(x.dtype) @ w_o


def short_conv_mixer(x, w_in, conv_w, w_out):
    S = x.shape[1]
    gate_b, gate_c, u = jnp.split(x @ w_in, 3, axis=-1)
    z = gate_c * u
    zp = jnp.pad(z, ((0, 0), (CONV_WIDTH - 1, 0), (0, 0)))
    conv = sum(conv_w[j] * zp[:, CONV_WIDTH - 1 - j: CONV_WIDTH - 1 - j + S] for j in range(CONV_WIDTH))
    return (gate_b * conv) @ w_out


def swiglu(x, w_gate, w_up, w_down):
    return (jax.nn.silu(x @ w_gate) * (x @ w_up)) @ w_down


def moe_swiglu(x, w_router, w_gate, w_up, w_down):
    logits = (x @ w_router).astype(jnp.float32)
    top_vals, top_idx = lax.top_k(logits, TOP_K)
    gates = jax.nn.softmax(top_vals, axis=-1)
    comb = jnp.sum(jax.nn.one_hot(top_idx, N_EXPERTS, dtype=jnp.float32) * gates[..., None], axis=-2)
    comb = comb.astype(x.dtype)
    out = jnp.zeros_like(x)
    for e in range(N_EXPERTS):
        out = out + comb[..., e:e + 1] * swiglu(x, w_gate[e], w_up[e], w_down[e])
    return out


def _normal(key, shape, scale):
    return jax.random.normal(key, shape, jnp.float32) * scale


def _ln_params(key, pfx):
    k1, k2 = jax.random.split(key)
    return {pfx + "_g": 1.0 + _normal(k1, (D_MODEL,), 0.02), pfx + "_b": _normal(k2, (D_MODEL,), 0.02)}


def _pool_params(key, pfx):
    k1, k2, k3 = jax.random.split(key, 3)
    return {pfx + "_w_in": _normal(k1, (D_MODEL, D_MODEL), D_MODEL ** -0.5),
            pfx + "_w_grp": _normal(k2, (POOL_GROUPS, POOL_GROUP_DIM, POOL_GROUP_DIM), POOL_GROUP_DIM ** -0.5 * DN_BETA),
            pfx + "_scale": 1.0 + _normal(k3, (D_MODEL,), 0.02)}


def _attn_params(key, pfx):
    k1, k2 = jax.random.split(key)
    qkv_scale = jnp.array([1.0, 1.0, DN_BETA], jnp.float32)[None, None, :, None] * D_MODEL ** -0.5
    w_qkv = _normal(k1, (D_MODEL, ATTN_GROUPS, 3, ATTN_INNER), 1.0) * qkv_scale
    return {pfx + "_w_qkv": w_qkv.reshape(D_MODEL, ATTN_GROUPS * 3 * ATTN_INNER),
            pfx + "_w_o": _normal(k2, (ATTN_INNER, D_MODEL), ATTN_INNER ** -0.5 * DN_BETA)}


def _conv_params(key, pfx):
    k1, k2, k3 = jax.random.split(key, 3)
    return {pfx + "_w_in": _normal(k1, (D_MODEL, 3 * D_MODEL), D_MODEL ** -0.5),
            pfx + "_w": _normal(k2, (CONV_WIDTH, D_MODEL), CONV_WIDTH ** -0.5),
            pfx + "_w_out": _normal(k3, (D_MODEL, D_MODEL), D_MODEL ** -0.5 * DN_BETA)}


def _ffn_params(key, pfx):
    k1, k2, k3 = jax.random.split(key, 3)
    return {pfx + "_w_gate": _normal(k1, (D_MODEL, D_FF), D_MODEL ** -0.5),
            pfx + "_w_up": _normal(k2, (D_MODEL, D_FF), D_MODEL ** -0.5),
            pfx + "_w_down": _normal(k3, (D_FF, D_MODEL), D_FF ** -0.5 * DN_BETA)}


def _moe_params(key, pfx):
    k0, k1, k2, k3 = jax.random.split(key, 4)
    return {pfx + "_w_router": _normal(k0, (D_MODEL, N_EXPERTS), D_MODEL ** -0.5),
            pfx + "_w_gate": _normal(k1, (N_EXPERTS, D_MODEL, D_FF_EXPERT), D_MODEL ** -0.5),
            pfx + "_w_up": _normal(k2, (N_EXPERTS, D_MODEL, D_FF_EXPERT), D_MODEL ** -0.5),
            pfx + "_w_down": _normal(k3, (N_EXPERTS, D_FF_EXPERT, D_MODEL), D_FF_EXPERT ** -0.5 * DN_BETA)}


def setup_inputs(seed: int = 0) -> dict:
    key = jax.random.key(seed)
    ks = jax.random.split(key, 2 + 4 * DEPTH)
    d = {}
    d["x"] = jax.random.normal(ks[0], (BATCH, SEQ, D_MODEL), jnp.float32)
    offsets = jax.random.randint(ks[1], (BATCH, 1), 0, 4096, dtype=jnp.int32)
    d["positions"] = jnp.arange(SEQ, dtype=jnp.int32)[None, :] + offsets
    mixer_makers = (_pool_params, _attn_params, _conv_params)
    mixer_names = ("pool", "attn", "conv")
    for i in range(DEPTH):
        km, kl1, kf, kl2 = ks[2 + 4 * i: 6 + 4 * i]
        kind = i % N_MIXERS
        d.update(mixer_makers[kind](km, "l%d_%s" % (i, mixer_names[kind])))
        d.update(_ln_params(kl1, "l%d_ln1" % i))
        if i % 2 == 0:
            d.update(_ffn_params(kf, "l%d_ffn" % i))
        else:
            d.update(_moe_params(kf, "l%d_moe" % i))
        d.update(_ln_params(kl2, "l%d_ln2" % i))
    return d


def reference(x, positions,
              l0_pool_w_in, l0_pool_w_grp, l0_pool_scale, l0_ln1_g, l0_ln1_b,
              l0_ffn_w_gate, l0_ffn_w_up, l0_ffn_w_down, l0_ln2_g, l0_ln2_b,
              l1_attn_w_qkv, l1_attn_w_o, l1_ln1_g, l1_ln1_b,
              l1_moe_w_router, l1_moe_w_gate, l1_moe_w_up, l1_moe_w_down, l1_ln2_g, l1_ln2_b,
              l2_conv_w_in, l2_conv_w, l2_conv_w_out, l2_ln1_g, l2_ln1_b,
              l2_ffn_w_gate, l2_ffn_w_up, l2_ffn_w_down, l2_ln2_g, l2_ln2_b,
              l3_pool_w_in, l3_pool_w_grp, l3_pool_scale, l3_ln1_g, l3_ln1_b,
              l3_moe_w_router, l3_moe_w_gate, l3_moe_w_up, l3_moe_w_down, l3_ln2_g, l3_ln2_b):
    cos, sin = rope_tables(positions)
    mixer_params = [(l0_pool_w_in, l0_pool_w_grp, l0_pool_scale),
                    (l1_attn_w_qkv, l1_attn_w_o),
                    (l2_conv_w_in, l2_conv_w, l2_conv_w_out),
                    (l3_pool_w_in, l3_pool_w_grp, l3_pool_scale)]
    ln1_params = [(l0_ln1_g, l0_ln1_b), (l1_ln1_g, l1_ln1_b), (l2_ln1_g, l2_ln1_b), (l3_ln1_g, l3_ln1_b)]
    ffn_params = [(l0_ffn_w_gate, l0_ffn_w_up, l0_ffn_w_down),
                  (l1_moe_w_router, l1_moe_w_gate, l1_moe_w_up, l1_moe_w_down),
                  (l2_ffn_w_gate, l2_ffn_w_up, l2_ffn_w_down),
                  (l3_moe_w_router, l3_moe_w_gate, l3_moe_w_up, l3_moe_w_down)]
    ln2_params = [(l0_ln2_g, l0_ln2_b), (l1_ln2_g, l1_ln2_b), (l2_ln2_g, l2_ln2_b), (l3_ln2_g, l3_ln2_b)]
    for i in range(DEPTH):
        kind = i % N_MIXERS
        if kind == 0:
            h = pool_mixer(x, *mixer_params[i])
        elif kind == 1:
            h = dilated_attention_mixer(x, cos, sin, *mixer_params[i])
        else:
            h = short_conv_mixer(x, *mixer_params[i])
        x = layer_norm(DN_ALPHA * x + h, *ln1_params[i])
        if i % 2 == 0:
            f = swiglu(x, *ffn_params[i])
        else:
            f = moe_swiglu(x, *ffn_params[i])
        x = layer_norm(DN_ALPHA * x + f, *ln2_params[i])
    return x
```

```cpp
#include <hip/hip_runtime.h>
#include <cstdio>
#include <cstdint>

#ifndef MK_CHECK
#define MK_CHECK 0
#endif
#ifndef MK_PER_PHASE
#define MK_PER_PHASE 0
#endif

#define LAS __attribute__((address_space(3)))
#define GAS __attribute__((address_space(1)))
typedef unsigned short bf16_t;
typedef short bf16x8 __attribute__((ext_vector_type(8)));
typedef short s16x4 __attribute__((ext_vector_type(4)));
typedef float f32x4 __attribute__((ext_vector_type(4)));
typedef float f32x2 __attribute__((ext_vector_type(2)));
typedef float f32x16 __attribute__((ext_vector_type(16)));
typedef unsigned u32x4 __attribute__((ext_vector_type(4)));
typedef unsigned u32x2 __attribute__((ext_vector_type(2)));

constexpr int M = 16384, D = 1024, SEQ = 2048, NBATCH = 8;
constexpr int FF = 2816, FFE = 3584, NE = 8;
constexpr int QKVW = 9216;
constexpr float ALPHA = 1.6817928305074292f;
constexpr float LN_EPS = 1e-5f;
constexpr float QSCALE = 0.125f * 1.4426950408889634f;
constexpr int MOE_ROWS_MAX = 32768 + 8 * 256;

__device__ __forceinline__ unsigned cvt_pk_bf16(float lo, float hi) { unsigned r; asm volatile("v_cvt_pk_bf16_f32 %0, %1, %2" : "=v"(r) : "v"(lo), "v"(hi)); return r; }
__device__ __forceinline__ unsigned f2bf(float f) { unsigned u = __builtin_bit_cast(unsigned, f); return (u + 0x7fffu + ((u >> 16) & 1u)) >> 16; }
__device__ __forceinline__ unsigned pk2(float lo, float hi) { return f2bf(lo) | (f2bf(hi) << 16); }
__device__ __forceinline__ float bf2f(unsigned b) { return __builtin_bit_cast(float, b << 16); }
__device__ __forceinline__ float bflo(unsigned w) { return __builtin_bit_cast(float, w << 16); }
__device__ __forceinline__ float bfhi(unsigned w) { return __builtin_bit_cast(float, w & 0xffff0000u); }
__device__ __forceinline__ float silu_f(float x) { return x * __builtin_amdgcn_rcpf(1.0f + __builtin_amdgcn_exp2f(-1.4426950408889634f * x)); }

namespace pg8 {
constexpr int BM = 256, BK = 64, HALF = 128, HTB = HALF * BK * 2  , STAGE_BYTES = 8 * HTB, NXCD = 8, WGM = 8;
__host__ __device__ __forceinline__ int lds_byte(int r, int c) { const int st = (r >> 4) * 2 + (c >> 5), rr = r & 15, cc = c & 31, ob = rr * 64 + cc * 2; return st * 1024 + (ob ^ (((ob >> 9) & 1) << 5)); }
__host__ __device__ __forceinline__ void stage_rc(int b, int& R, int& C) { const int st = b / 1024, sb = b % 1024, swz = sb ^ (((sb >> 9) & 1) << 5); R = (st >> 1) * 16 + swz / 64; C = (st & 1) * 32 + (swz % 64) / 2; }
__host__ __device__ __forceinline__ int perm32(int rho) { const int n = rho >> 4, i = rho & 15; return 8 * (i >> 2) + 4 * n + (i & 3); }

struct Unit { int pm, pn; unsigned ao, bo; };
struct Gemm { const bf16_t* A; const bf16_t* Bt; int lda, ldb, K; };

struct StaticOrder {
    int nM, nN, nwg, G, c; unsigned ao_pn;
    __device__ void init(int nM_, int nN_, int G_, int c_, unsigned ao_pn_ = 0u) { nM = nM_; nN = nN_; nwg = nM * nN; G = G_; c = c_; ao_pn = ao_pn_; }
    __device__ __forceinline__ bool next(int i, Unit& u) const {
        const long L = (long)i * G + c; if (L >= nwg) return false;
        int wgid = (int)L; { const int q = nwg / NXCD, r = nwg % NXCD, xcd = wgid % NXCD, off = wgid / NXCD; wgid = (xcd < r ? xcd * (q + 1) : r * (q + 1) + (xcd - r) * q) + off; }
        const int nig = WGM * nN, gid = wgid / nig, fm = gid * WGM, gsz = (nM - fm) < WGM ? (nM - fm) : WGM;
        u.pm = fm + ((wgid % nig) % gsz); u.pn = (wgid % nig) / gsz; u.ao = ao_pn * (unsigned)u.pn; u.bo = 0u; return true;
    }
};
struct MoeOrder {
    StaticOrder so; int o1, o2, o3, o4, o5, o6, o7; unsigned estride;
    __device__ __forceinline__ bool next(int i, Unit& u) const {
        if (!so.next(i, u)) return false;
        const int row = u.pm * 256;
        const int e = (row >= o1) + (row >= o2) + (row >= o3) + (row >= o4) + (row >= o5) + (row >= o6) + (row >= o7);
        u.bo = (unsigned)e * estride; return true;
    }
};

struct EpiBf16 {
    static constexpr bool PERM = true;
    bf16_t* O; int ldc;
    __device__ __forceinline__ void operator()(const f32x4 (&acc)[2][2][4][2], const Unit& u, int wr, int wc, int fr, int fq) const {
        const int row0 = u.pm * BM + wr * 64 + fr, col0 = u.pn * BM + wc * 32 + 8 * fq;
#pragma unroll
        for (int ai = 0; ai < 2; ++ai)
#pragma unroll
            for (int m = 0; m < 4; ++m) { bf16_t* rowp = O + (size_t)(row0 + ai * HALF + m * 16) * ldc + col0;
#pragma unroll
                for (int bj = 0; bj < 2; ++bj) { const f32x4 v0 = acc[ai][bj][m][0], v1 = acc[ai][bj][m][1];
                    u32x4 w; w.x = cvt_pk_bf16(v0[0], v0[1]); w.y = cvt_pk_bf16(v0[2], v0[3]); w.z = cvt_pk_bf16(v1[0], v1[1]); w.w = cvt_pk_bf16(v1[2], v1[3]);
                    *(u32x4*)(rowp + bj * HALF) = w; } }
    }
};
struct EpiSwiGLU {
    static constexpr bool PERM = true;
    bf16_t* O; int ldc;
    __device__ __forceinline__ void operator()(const f32x4 (&acc)[2][2][4][2], const Unit& u, int wr, int wc, int fr, int fq) const {
        const int row0 = u.pm * BM + wr * 64 + fr, col0 = u.pn * HALF + wc * 32 + 8 * fq;
#pragma unroll
        for (int ai = 0; ai < 2; ++ai)
#pragma unroll
            for (int m = 0; m < 4; ++m) { bf16_t* rowp = O + (size_t)(row0 + ai * HALF + m * 16) * ldc + col0;
                const f32x4 g0 = acc[ai][0][m][0], g1 = acc[ai][0][m][1], u0 = acc[ai][1][m][0], u1 = acc[ai][1][m][1];
                float h[8];
#pragma unroll
                for (int j = 0; j < 4; ++j) { h[j] = silu_f(g0[j]) * u0[j]; h[4 + j] = silu_f(g1[j]) * u1[j]; }
                u32x4 w; w.x = cvt_pk_bf16(h[0], h[1]); w.y = cvt_pk_bf16(h[2], h[3]); w.z = cvt_pk_bf16(h[4], h[5]); w.w = cvt_pk_bf16(h[6], h[7]);
                *(u32x4*)rowp = w; }
    }
};
struct EpiConvIn {
    static constexpr bool PERM = true;
    bf16_t* Bo; bf16_t* Zo;
    __device__ __forceinline__ void operator()(const f32x4 (&acc)[2][2][4][2], const Unit& u, int wr, int wc, int fr, int fq) const {
        const int row0 = u.pm * BM + wr * 64 + fr;
        if (u.pn < 4) {
            const int col0 = u.pn * BM + wc * 32 + 8 * fq;
#pragma unroll
            for (int ai = 0; ai < 2; ++ai)
#pragma unroll
                for (int m = 0; m < 4; ++m) { bf16_t* rowp = Bo + (size_t)(row0 + ai * HALF + m * 16) * D + col0;
#pragma unroll
                    for (int bj = 0; bj < 2; ++bj) { const f32x4 v0 = acc[ai][bj][m][0], v1 = acc[ai][bj][m][1];
                        u32x4 w; w.x = cvt_pk_bf16(v0[0], v0[1]); w.y = cvt_pk_bf16(v0[2], v0[3]); w.z = cvt_pk_bf16(v1[0], v1[1]); w.w = cvt_pk_bf16(v1[2], v1[3]);
                        *(u32x4*)(rowp + bj * HALF) = w; } }
        } else {
            const int col0 = (u.pn - 4) * HALF + wc * 32 + 8 * fq;
#pragma unroll
            for (int ai = 0; ai < 2; ++ai)
#pragma unroll
                for (int m = 0; m < 4; ++m) { bf16_t* rowp = Zo + (size_t)(row0 + ai * HALF + m * 16) * D + col0;
                    const f32x4 c0 = acc[ai][0][m][0], c1 = acc[ai][0][m][1], u0 = acc[ai][1][m][0], u1 = acc[ai][1][m][1];
                    u32x4 w; w.x = cvt_pk_bf16(c0[0] * u0[0], c0[1] * u0[1]); w.y = cvt_pk_bf16(c0[2] * u0[2], c0[3] * u0[3]); w.z = cvt_pk_bf16(c1[0] * u1[0], c1[1] * u1[1]); w.w = cvt_pk_bf16(c1[2] * u1[2], c1[3] * u1[3]);
                    *(u32x4*)rowp = w; }
        }
    }
};
struct EpiQKV {
    static constexpr bool PERM = true;
    bf16_t* O; const float* cosT; const float* sinT;
    __device__ __forceinline__ void operator()(const f32x4 (&acc)[2][2][4][2], const Unit& u, int wr, int wc, int fr, int fq) const {
        const int row0 = u.pm * BM + wr * 64 + fr, col0 = u.pn * BM + wc * 32 + 8 * fq;
        const int kind = (u.pn % 12) >> 2;
        const bool rot = (kind < 2) && ((wc & 1) == 0);
        const float qs = (kind == 0) ? QSCALE : 1.0f;
#pragma unroll
        for (int ai = 0; ai < 2; ++ai)
#pragma unroll
            for (int m = 0; m < 4; ++m) { const int row = row0 + ai * HALF + m * 16; bf16_t* rowp = O + (size_t)row * QKVW + col0;
                f32x4 cs0 = {1.f, 1.f, 1.f, 1.f}, cs1 = cs0, sn0 = {0.f, 0.f, 0.f, 0.f}, sn1 = sn0;
                if (rot) { cs0 = *(const f32x4*)(cosT + (size_t)row * 8); cs1 = *(const f32x4*)(cosT + (size_t)row * 8 + 4); sn0 = *(const f32x4*)(sinT + (size_t)row * 8); sn1 = *(const f32x4*)(sinT + (size_t)row * 8 + 4); }
#pragma unroll
                for (int bj = 0; bj < 2; ++bj) { f32x4 v0 = acc[ai][bj][m][0], v1 = acc[ai][bj][m][1];
                    if (rot) {
                        f32x4 p0, p1;
#pragma unroll
                        for (int j = 0; j < 4; ++j) { p0[j] = __shfl_xor(v0[j], 16); p1[j] = __shfl_xor(v1[j], 16); }
                        if (fq == 0) { v0 = v0 * cs0 - p0 * sn0; v1 = v1 * cs1 - p1 * sn1; }
                        else if (fq == 1) { v0 = p0 * sn0 + v0 * cs0; v1 = p1 * sn1 + v1 * cs1; }
                    }
                    v0 = v0 * qs; v1 = v1 * qs;
                    u32x4 w; w.x = cvt_pk_bf16(v0[0], v0[1]); w.y = cvt_pk_bf16(v0[2], v0[3]); w.z = cvt_pk_bf16(v1[0], v1[1]); w.w = cvt_pk_bf16(v1[2], v1[3]);
                    *(u32x4*)(rowp + bj * HALF) = w; } }
    }
};
struct EpiPre {
    static constexpr bool PERM = false;
    const float* X; float* P; const float* scale;
    __device__ __forceinline__ void operator()(const f32x4 (&acc)[2][2][4][2], const Unit& u, int wr, int wc, int fr, int fq) const {
        const int row0 = u.pm * BM + wr * 64 + fr, col0 = u.pn * BM + wc * 32 + 4 * fq;
        f32x4 sc[2][2];
#pragma unroll
        for (int bj = 0; bj < 2; ++bj)
#pragma unroll
            for (int n = 0; n < 2; ++n) sc[bj][n] = scale ? *(const f32x4*)(scale + col0 + bj * HALF + n * 16) : (f32x4){1.f, 1.f, 1.f, 1.f};
#pragma unroll
        for (int ai = 0; ai < 2; ++ai)
#pragma unroll
            for (int m = 0; m < 4; ++m) { const size_t off = (size_t)(row0 + ai * HALF + m * 16) * D + col0;
#pragma unroll
                for (int bj = 0; bj < 2; ++bj)
#pragma unroll
                    for (int n = 0; n < 2; ++n) { const f32x4 xv = *(const f32x4*)(X + off + bj * HALF + n * 16);
                        *(f32x4*)(P + off + bj * HALF + n * 16) = xv * ALPHA + acc[ai][bj][m][n] * sc[bj][n]; } }
    }
};
struct EpiMoeDown {
    static constexpr bool PERM = true;
    bf16_t* O; const float* rowgate;
    __device__ __forceinline__ void operator()(const f32x4 (&acc)[2][2][4][2], const Unit& u, int wr, int wc, int fr, int fq) const {
        const int row0 = u.pm * BM + wr * 64 + fr, col0 = u.pn * BM + wc * 32 + 8 * fq;
#pragma unroll
        for (int ai = 0; ai < 2; ++ai)
#pragma unroll
            for (int m = 0; m < 4; ++m) { const int row = row0 + ai * HALF + m * 16; const float gt = rowgate[row]; bf16_t* rowp = O + (size_t)row * D + col0;
#pragma unroll
                for (int bj = 0; bj < 2; ++bj) { const f32x4 v0 = acc[ai][bj][m][0] * gt, v1 = acc[ai][bj][m][1] * gt;
                    u32x4 w; w.x = cvt_pk_bf16(v0[0], v0[1]); w.y = cvt_pk_bf16(v0[2], v0[3]); w.z = cvt_pk_bf16(v1[0], v1[1]); w.w = cvt_pk_bf16(v1[2], v1[3]);
                    *(u32x4*)(rowp + bj * HALF) = w; } }
    }
};

template <class Epi, class Sched, bool ALIGN_EPI = true, bool SP2 = true>
__device__ __forceinline__ void gemm_phase(LAS unsigned char* lds, const Gemm g, const Sched& S, const Epi& E) {
    const int tid = threadIdx.x, wid = __builtin_amdgcn_readfirstlane(tid >> 6), lane = tid & 63, wr = wid >> 2, wc = wid & 3, fr = lane & 15, fq = lane >> 4;
    const int K = g.K, nt = K / BK;
    unsigned voffA[2], voffB[2];
#pragma unroll
    for (int i = 0; i < 2; ++i) { int R, C; stage_rc(tid * 16 + i * 8192, R, C); const int Rb = Epi::PERM ? ((R & ~31) + perm32(R & 31)) : R;
        voffA[i] = (unsigned)(R * g.lda + C) * 2u; voffB[i] = (unsigned)(Rb * g.ldb + C) * 2u; }
    const size_t kstep = (size_t)(BK * 2);
    const size_t hstepA = (size_t)HALF * g.lda * 2, hstepB = (size_t)HALF * g.ldb * 2;
    const size_t tstepA = 2 * hstepA, tstepB = 2 * hstepB;
    const unsigned ldsw = (unsigned)wid * 1024u;
    const int aoff = lds_byte(wr * 64 + fr, fq * 8), boff = lds_byte(wc * 32 + fr, fq * 8);
#define PG8_SA(b, h) (((b) * 2 + (h)) * HTB)
#define PG8_SB(b, h) ((4 + (b) * 2 + (h)) * HTB)
#define PG8_STAGE(bufoff, gbase, voff) do { _Pragma("unroll") for (int _i = 0; _i < 2; ++_i) \
        __builtin_amdgcn_global_load_lds((const unsigned*)((const char*)(gbase) + (voff)[_i]), (LAS unsigned*)(lds + (bufoff) + ldsw + _i * 8192), 16, 0, 0); } while (0)
#define PG8_LDA(dst, b, h) do { _Pragma("unroll") for (int m = 0; m < 4; ++m) _Pragma("unroll") for (int k = 0; k < 2; ++k) dst[m][k] = *(const LAS bf16x8*)(lds + PG8_SA(b, h) + aoff + m * 2048 + k * 1024); } while (0)
#define PG8_LDB(dst, b, h) do { _Pragma("unroll") for (int n = 0; n < 2; ++n) _Pragma("unroll") for (int k = 0; k < 2; ++k) dst[n][k] = *(const LAS bf16x8*)(lds + PG8_SB(b, h) + boff + n * 2048 + k * 1024); } while (0)
#define PG8_MMA(ai, bj, At, Bt) do { __builtin_amdgcn_s_setprio(1); _Pragma("unroll") for (int m = 0; m < 4; ++m) _Pragma("unroll") for (int n = 0; n < 2; ++n) _Pragma("unroll") for (int k = 0; k < 2; ++k) \
        acc[ai][bj][m][n] = __builtin_amdgcn_mfma_f32_16x16x32_bf16(Bt[n][k], At[m][k], acc[ai][bj][m][n], 0, 0, 0); __builtin_amdgcn_s_setprio(0); } while (0)
#define PG8_WAIT_V(n) asm volatile("s_waitcnt vmcnt(" #n ")" ::: "memory")
#define PG8_WAIT_L(n) asm volatile("s_waitcnt lgkmcnt(" #n ")" ::: "memory")
#define PG8_BAR __builtin_amdgcn_s_barrier()
#define PG8_SCHED __builtin_amdgcn_sched_barrier(0)
    Unit cur, nxt; int ui = 0;
    if (!S.next(0, cur)) return;
    f32x4 acc[2][2][4][2];
#pragma unroll
    for (int a = 0; a < 2; ++a)
#pragma unroll
        for (int b = 0; b < 2; ++b)
#pragma unroll
            for (int m = 0; m < 4; ++m)
#pragma unroll
                for (int n = 0; n < 2; ++n) acc[a][b][m][n] = (f32x4){0.f, 0.f, 0.f, 0.f};
    bf16x8 At[4][2], B0[2][2], B1[2][2];
    const char* cA = (const char*)g.A + (size_t)cur.pm * tstepA + cur.ao; const char* cB = (const char*)g.Bt + (size_t)cur.pn * tstepB + cur.bo;
    if constexpr (SP2) {
        PG8_STAGE(PG8_SB(0, 0), cB, voffB); PG8_STAGE(PG8_SB(0, 1), cB + hstepB, voffB); PG8_STAGE(PG8_SA(0, 0), cA, voffA); PG8_STAGE(PG8_SA(0, 1), cA + hstepA, voffA);
        if (wr == 1) PG8_BAR;
        PG8_WAIT_V(2); PG8_BAR;
        PG8_STAGE(PG8_SB(1, 0), cB + kstep, voffB); PG8_STAGE(PG8_SA(1, 0), cA + kstep, voffA); PG8_STAGE(PG8_SB(1, 1), cB + hstepB + kstep, voffB);
        PG8_WAIT_V(6); PG8_BAR;
    } else {
        PG8_STAGE(PG8_SB(0, 0), cB, voffB); PG8_STAGE(PG8_SA(0, 0), cA, voffA); PG8_STAGE(PG8_SB(0, 1), cB + hstepB, voffB); PG8_STAGE(PG8_SA(0, 1), cA + hstepA, voffA);
        if (wr == 1) PG8_BAR;
        PG8_WAIT_V(4); PG8_BAR;
        PG8_STAGE(PG8_SB(1, 0), cB + kstep, voffB); PG8_STAGE(PG8_SA(1, 0), cA + kstep, voffA); PG8_STAGE(PG8_SB(1, 1), cB + hstepB + kstep, voffB);
        PG8_WAIT_V(6); PG8_BAR;
    }
    for (;;) {
        const bool has_next = S.next(ui + 1, nxt);
        const char* nA = has_next ? (const char*)g.A + (size_t)nxt.pm * tstepA + nxt.ao : cA; const char* nB = has_next ? (const char*)g.Bt + (size_t)nxt.pn * tstepB + nxt.bo : cB;
        for (int t = 0; t < nt; t += 2) {
            const bool last = (t == nt - 2);
            const char* a1 = cA + (size_t)(t + 1) * kstep;
            const char* a2 = last ? nA : cA + (size_t)(t + 2) * kstep; const char* b2 = last ? nB : cB + (size_t)(t + 2) * kstep;
            const char* a3 = a2 + kstep; const char* b3 = b2 + kstep;
            if constexpr (SP2) {
            PG8_LDB(B0, 0, 0); PG8_LDB(B1, 0, 1); PG8_SCHED; PG8_LDA(At, 0, 0); PG8_STAGE(PG8_SA(1, 1), a1 + hstepA, voffA);
            PG8_WAIT_V(8); PG8_WAIT_L(0); PG8_BAR; PG8_MMA(0, 0, At, B0); PG8_MMA(0, 1, At, B1); PG8_BAR; PG8_SCHED;
            PG8_LDA(At, 0, 1); PG8_STAGE(PG8_SB(0, 0), b2, voffB); PG8_STAGE(PG8_SB(0, 1), b2 + hstepB, voffB); PG8_STAGE(PG8_SA(0, 0), a2, voffA);
            PG8_WAIT_V(8); PG8_WAIT_L(0); PG8_BAR; PG8_MMA(1, 0, At, B0); PG8_MMA(1, 1, At, B1); PG8_BAR; PG8_SCHED;
            PG8_LDB(B0, 1, 0); PG8_LDB(B1, 1, 1); PG8_SCHED; PG8_LDA(At, 1, 0); PG8_STAGE(PG8_SA(0, 1), a2 + hstepA, voffA);
            PG8_WAIT_V(8); PG8_WAIT_L(0); PG8_BAR; PG8_MMA(0, 0, At, B0); PG8_MMA(0, 1, At, B1); PG8_BAR; PG8_SCHED;
            PG8_LDA(At, 1, 1); PG8_STAGE(PG8_SB(1, 0), b3, voffB); PG8_STAGE(PG8_SB(1, 1), b3 + hstepB, voffB); PG8_STAGE(PG8_SA(1, 0), a3, voffA);
            PG8_WAIT_V(8); PG8_WAIT_L(0); PG8_BAR; PG8_MMA(1, 0, At, B0); PG8_MMA(1, 1, At, B1); PG8_BAR; PG8_SCHED;
            } else {
            PG8_LDB(B0, 0, 0); PG8_SCHED; PG8_LDA(At, 0, 0); PG8_STAGE(PG8_SA(1, 1), a1 + hstepA, voffA);
            PG8_WAIT_L(8); PG8_BAR; PG8_WAIT_L(0); PG8_MMA(0, 0, At, B0); PG8_BAR; PG8_SCHED;
            PG8_LDB(B1, 0, 1); PG8_STAGE(PG8_SB(0, 0), b2, voffB);
            PG8_BAR; PG8_WAIT_L(0); PG8_MMA(0, 1, At, B1); PG8_BAR;
            PG8_LDA(At, 0, 1); PG8_STAGE(PG8_SA(0, 0), a2, voffA);
            PG8_BAR; PG8_WAIT_L(0); PG8_MMA(1, 0, At, B0); PG8_BAR; PG8_SCHED;
            PG8_STAGE(PG8_SB(0, 1), b2 + hstepB, voffB);
            PG8_WAIT_V(6); PG8_BAR; PG8_MMA(1, 1, At, B1); PG8_BAR;
            PG8_LDB(B0, 1, 0); PG8_SCHED; PG8_LDA(At, 1, 0); PG8_STAGE(PG8_SA(0, 1), a2 + hstepA, voffA);
            PG8_WAIT_L(8); PG8_BAR; PG8_WAIT_L(0); PG8_MMA(0, 0, At, B0); PG8_BAR; PG8_SCHED;
            PG8_LDB(B1, 1, 1); PG8_STAGE(PG8_SB(1, 0), b3, voffB);
            PG8_BAR; PG8_WAIT_L(0); PG8_MMA(0, 1, At, B1); PG8_BAR;
            PG8_LDA(At, 1, 1); PG8_STAGE(PG8_SA(1, 0), a3, voffA);
            PG8_BAR; PG8_WAIT_L(0); PG8_MMA(1, 0, At, B0); PG8_BAR; PG8_SCHED;
            PG8_STAGE(PG8_SB(1, 1), b3 + hstepB, voffB);
            PG8_WAIT_V(6); PG8_BAR; PG8_MMA(1, 1, At, B1); PG8_BAR;
            }
        }
        if constexpr (ALIGN_EPI) { if (wr == 0) PG8_BAR; }
        E(acc, cur, wr, wc, fr, fq);
        if (!has_next) break;
#pragma unroll
        for (int a = 0; a < 2; ++a)
#pragma unroll
            for (int b = 0; b < 2; ++b)
#pragma unroll
                for (int m = 0; m < 4; ++m)
#pragma unroll
                    for (int n = 0; n < 2; ++n) acc[a][b][m][n] = (f32x4){0.f, 0.f, 0.f, 0.f};
        cur = nxt; cA = nA; cB = nB; ++ui;
        if constexpr (ALIGN_EPI) { if (wr == 1) PG8_BAR; }
    }
    PG8_WAIT_V(0);
    if constexpr (!ALIGN_EPI) { if (wr == 0) PG8_BAR; }
    PG8_BAR;
#undef PG8_SA
#undef PG8_SB
#undef PG8_STAGE
#undef PG8_LDA
#undef PG8_LDB
#undef PG8_MMA
#undef PG8_WAIT_V
#undef PG8_WAIT_L
#undef PG8_BAR
#undef PG8_SCHED
}
}

constexpr size_t MiB = 1u << 20;
constexpr size_t WS_CTL = 0, CTL_ZERO_BYTES = 1 * MiB;
constexpr size_t WS_ROPE = 1 * MiB;
constexpr size_t WS_MISC = 2 * MiB;
constexpr size_t WS_XF = 4 * MiB;
constexpr size_t WS_XB = 68 * MiB;
constexpr size_t WS_PRE = 100 * MiB;
constexpr size_t WS_WB = 164 * MiB;
constexpr size_t WS_BIG = 354 * MiB;
constexpr size_t WS_AUX = 642 * MiB;
constexpr size_t WS_END = 778 * MiB;
constexpr size_t MS_SEL = 0, MS_GATE = 128 * 1024, MS_POS = 256 * 1024, MS_WGCNT = 384 * 1024, MS_OFF = 392 * 1024, MS_ROWGATE = 400 * 1024;
constexpr size_t WB_MIX0 = 0;
constexpr size_t WB_MIX1 = (size_t)QKVW * D;
constexpr size_t WB_FFN0 = 11u * 1048576u;
constexpr size_t WB_FFN1_DENSE = WB_FFN0 + (size_t)2 * FF * D;
constexpr size_t WB_FFN1_MOE = WB_FFN0 + (size_t)NE * 2 * FFE * D;
static_assert((WB_FFN1_MOE + (size_t)NE * D * FFE) * 2 <= 190 * MiB, "weights region");
static_assert(WB_MIX1 + (size_t)D * D <= WB_FFN0, "mixer weights region");
constexpr size_t BG_QKV = 0;
constexpr size_t BG_HID = 0;
constexpr size_t BG_U = 256 * MiB;
constexpr size_t BG_P = 224 * MiB;
constexpr size_t BG_G = 192 * MiB;
static_assert((size_t)MOE_ROWS_MAX * FFE * 2 <= 288 * MiB && (size_t)M * QKVW * 2 <= 288 * MiB, "big region");
constexpr size_t AX_OG = 0;
constexpr size_t AX_LSE = 96 * MiB;
constexpr size_t AX_ATT = 100 * MiB;
constexpr size_t AX_XPERM = 0;
constexpr size_t AX_Y = 68 * MiB;
static_assert(AX_Y + (size_t)MOE_ROWS_MAX * D * 2 <= 136 * MiB && AX_ATT + 32 * MiB <= 136 * MiB, "aux region");

constexpr int CW_BAR = 4096;
constexpr int CW_CHK = 16384;
constexpr int RING_BYTES = 131072;
constexpr int LDSCTL_OFF = RING_BYTES, MISC_OFF = LDSCTL_OFF + 320;
constexpr int LDS_BYTES = 147456;
constexpr int NWAVES = 8;

#define LDS_WAIT() asm volatile("s_waitcnt lgkmcnt(0)" ::: "memory")
#define VM_WAIT() asm volatile("s_waitcnt vmcnt(0)" ::: "memory")

#define XB_TMO      128
#define XB_XCNT(j)  (256  + 64 * (j))
#define XB_XSUB(j)  (1280 + 64 * (j))
#define XB_XGEN(j)  (2304 + 64 * (j))
#define XB_TOP      3328
#define XB_TOPGEN   3392
#define XCD_BAR_WORDS 3456
#define XB_SPIN_CAP (1u << 18)

__device__ __forceinline__ unsigned xb_ld(unsigned* p)              { return __hip_atomic_load(p, __ATOMIC_RELAXED, __HIP_MEMORY_SCOPE_AGENT); }
__device__ __forceinline__ unsigned xb_add(unsigned* p, unsigned v) { return __hip_atomic_fetch_add(p, v, __ATOMIC_RELAXED, __HIP_MEMORY_SCOPE_AGENT); }
__device__ __forceinline__ unsigned xb_xcc_id() { return (unsigned)__builtin_amdgcn_s_getreg((3 << 11) | 20) & 0xFu; }
#define XB_SPIN(cond, bar) do { unsigned _sp = 0; while (cond) { __builtin_amdgcn_s_sleep(1); \
    if ((++_sp & 255u) == 0u) { if (xb_ld(&(bar)[XB_TMO])) break; if (_sp > XB_SPIN_CAP) { atomicAdd(&(bar)[XB_TMO], 1u); break; } } } } while (0)

struct XcdBarrier {
    unsigned* bar; unsigned x;
    volatile LAS unsigned* st;
};
__device__ __forceinline__ XcdBarrier xcd_barrier_post(unsigned* bar, volatile LAS unsigned* st) {
    XcdBarrier b; b.bar = bar; b.x = xb_xcc_id(); b.st = st;
    if (threadIdx.x == 0) (void)xb_add(&bar[XB_XCNT(b.x)], 1u);
    return b;
}
__device__ __forceinline__ void xcd_barrier_complete(unsigned* bar, unsigned x, unsigned& nloc, unsigned& nx) {
    const unsigned G = gridDim.x * gridDim.y * gridDim.z;
    unsigned sum, cnt, mine, sp = 0u;
    for (;;) {
        sum = 0u; cnt = 0u; mine = 0u;
#pragma unroll
        for (unsigned j = 0; j < 16; ++j) { const unsigned c = xb_ld(&bar[XB_XCNT(j)]); sum += c; cnt += (c > 0u) ? 1u : 0u; mine = (j == x) ? c : mine; }
        if (sum == G) break;
        __builtin_amdgcn_s_sleep(1);
        if ((++sp & 255u) == 0u) { if (xb_ld(&bar[XB_TMO])) break; if (sp > XB_SPIN_CAP) { atomicAdd(&bar[XB_TMO], 1u); break; } }
    }
    nloc = mine > 0u ? mine : 1u; nx = cnt > 0u ? cnt : 1u;
}
__device__ __forceinline__ void xcd_barrier(const XcdBarrier& b) {
    asm volatile("s_waitcnt vmcnt(0)" ::: "memory");
    __syncthreads();
    if (threadIdx.x == 0) {
        unsigned* bar = b.bar;
        __builtin_amdgcn_s_waitcnt(0);
        unsigned nloc = b.st[0], nx = b.st[1];
        if (nloc == 0u) { xcd_barrier_complete(bar, b.x, nloc, nx); b.st[0] = nloc; b.st[1] = nx; }
        const unsigned old = xb_add(&bar[XB_XSUB(b.x)], 1u);
        const unsigned gen = old / nloc;
        if (old + 1u == (gen + 1u) * nloc) {
            __builtin_amdgcn_fence(__ATOMIC_RELEASE, "agent");
            asm volatile("s_waitcnt vmcnt(0)" ::: "memory");
            const unsigned og = xb_add(&bar[XB_TOP], 1u);
            const unsigned tg = og / nx;
            if (og + 1u == (tg + 1u) * nx) xb_add(&bar[XB_TOPGEN], 1u);
            else XB_SPIN(xb_ld(&bar[XB_TOPGEN]) == tg, bar);
            __builtin_amdgcn_fence(__ATOMIC_ACQUIRE, "agent");
            xb_add(&bar[XB_XGEN(b.x)], 1u);
            asm volatile("s_waitcnt vmcnt(0)" ::: "memory");
        } else {
            XB_SPIN(xb_ld(&bar[XB_XGEN(b.x)]) == gen, bar);
            __builtin_amdgcn_fence(__ATOMIC_ACQUIRE, "agent");
            asm volatile("s_waitcnt vmcnt(0)" ::: "memory");
        }
    }
    __syncthreads();
}

__device__ __forceinline__ float wave_sum(float v) {
#pragma unroll
    for (int o = 1; o < 64; o <<= 1) v += __shfl_xor(v, o);
    return v;
}
struct Ctx { LAS unsigned char* lds; int tid, lane, wave, G, bid; };

struct CvtJob { const float* src; bf16_t* dst; int K, N, sld, nbatch, mode; };
__device__ __forceinline__ int cvt_items(const CvtJob& J) { return J.nbatch * (J.K / 64) * (J.N / 32); }
__device__ __forceinline__ void cvt_item(const CvtJob& J, int item, LAS float* scr, int lane) {
    const int nblk = J.N / 32, per = (J.K / 64) * nblk, e = item / per, rem = item - e * per, kb = rem / nblk, nb = rem - kb * nblk, k0 = 64 * kb, n0 = 32 * nb;
    const float* W = J.src + (size_t)e * J.K * J.sld;
    const int drows = J.mode ? 2 * J.N : J.N;
    const int drow0 = J.mode ? (256 * (n0 >> 7) + (n0 & 127) + (J.mode == 2 ? 128 : 0)) : n0;
    bf16_t* WT = J.dst + ((size_t)e * drows + drow0) * J.K;
#pragma unroll 8
    for (int i = 0; i < 32; ++i) { const int kk = 2 * i + (lane >> 5); scr[kk * 33 + (lane & 31)] = W[(size_t)(k0 + kk) * J.sld + n0 + (lane & 31)]; }
    LDS_WAIT(); asm volatile("" ::: "memory");
    const int c = lane & 7;
#pragma unroll
    for (int j = 0; j < 4; ++j) { const int n = (lane >> 3) + 8 * j; const LAS float* s = scr + (8 * c) * 33 + n;
        u32x4 o; o.x = pk2(s[0 * 33], s[1 * 33]); o.y = pk2(s[2 * 33], s[3 * 33]); o.z = pk2(s[4 * 33], s[5 * 33]); o.w = pk2(s[6 * 33], s[7 * 33]);
        *(u32x4*)(WT + (size_t)n * J.K + k0 + 8 * c) = o; }
    LDS_WAIT(); asm volatile("" ::: "memory");
}
#define CVT_RUN(J) do { const int _n = cvt_items(J); for (; it < base + _n; it += NGW) cvt_item(J, it - base, scr, C.lane); base += _n; } while (0)

struct Params {
    const float* in[43]; const int* positions; float* out; unsigned char* ws; int step_lo, step_hi, pad0, pad1;
};

__device__ __forceinline__ void convert_pool_ffn(const Ctx& C, const Params& P, int ib  ) {
    LAS float* scr = (LAS float*)(C.lds + C.wave * 16384);
    bf16_t* WB = (bf16_t*)(P.ws + WS_WB);
    const int gw = C.bid * NWAVES + C.wave, NGW = C.G * NWAVES; int it = gw, base = 0;
    const CvtJob j0{P.in[ib + 0], WB + WB_MIX0, D, D, D, 1, 0};
    const CvtJob j1{P.in[ib + 1], WB + WB_MIX1, 256, 256, 256, 4, 0};
    const CvtJob j2{P.in[ib + 5], WB + WB_FFN0, D, FF, FF, 1, 1};
    const CvtJob j3{P.in[ib + 6], WB + WB_FFN0, D, FF, FF, 1, 2};
    const CvtJob j4{P.in[ib + 7], WB + WB_FFN1_DENSE, FF, D, D, 1, 0};
    CVT_RUN(j0); CVT_RUN(j1); CVT_RUN(j2); CVT_RUN(j3); CVT_RUN(j4);
}
__device__ __forceinline__ void convert_attn_moe(const Ctx& C, const Params& P, int ib) {
    LAS float* scr = (LAS float*)(C.lds + C.wave * 16384);
    bf16_t* WB = (bf16_t*)(P.ws + WS_WB);
    const int gw = C.bid * NWAVES + C.wave, NGW = C.G * NWAVES; int it = gw, base = 0;
    const CvtJob j0{P.in[ib + 0], WB + WB_MIX0, D, QKVW, QKVW, 1, 0};
    const CvtJob j1{P.in[ib + 1], WB + WB_MIX1, D, D, D, 1, 0};
    const CvtJob j2{P.in[ib + 5], WB + WB_FFN0, D, FFE, FFE, NE, 1};
    const CvtJob j3{P.in[ib + 6], WB + WB_FFN0, D, FFE, FFE, NE, 2};
    const CvtJob j4{P.in[ib + 7], WB + WB_FFN1_MOE, FFE, D, D, NE, 0};
    CVT_RUN(j0); CVT_RUN(j1); CVT_RUN(j2); CVT_RUN(j3); CVT_RUN(j4);
}
__device__ __forceinline__ void convert_conv_ffn(const Ctx& C, const Params& P, int ib) {
    LAS float* scr = (LAS float*)(C.lds + C.wave * 16384);
    bf16_t* WB = (bf16_t*)(P.ws + WS_WB);
    const int gw = C.bid * NWAVES + C.wave, NGW = C.G * NWAVES; int it = gw, base = 0;
    const CvtJob j0{P.in[ib + 0], WB + WB_MIX0, D, D, 3 * D, 1, 0};
    const CvtJob j1{P.in[ib + 0] + D, WB + WB_MIX0 + (size_t)D * D, D, D, 3 * D, 1, 1};
    const CvtJob j2{P.in[ib + 0] + 2 * D, WB + WB_MIX0 + (size_t)D * D, D, D, 3 * D, 1, 2};
    const CvtJob j3{P.in[ib + 2], WB + WB_MIX1, D, D, D, 1, 0};
    const CvtJob j4{P.in[ib + 5], WB + WB_FFN0, D, FF, FF, 1, 1};
    const CvtJob j5{P.in[ib + 6], WB + WB_FFN0, D, FF, FF, 1, 2};
    const CvtJob j6{P.in[ib + 7], WB + WB_FFN1_DENSE, FF, D, D, 1, 0};
    CVT_RUN(j0); CVT_RUN(j1); CVT_RUN(j2); CVT_RUN(j3); CVT_RUN(j4); CVT_RUN(j5); CVT_RUN(j6);
}
__device__ __forceinline__ void convert_pool_moe(const Ctx& C, const Params& P, int ib) {
    LAS float* scr = (LAS float*)(C.lds + C.wave * 16384);
    bf16_t* WB = (bf16_t*)(P.ws + WS_WB);
    const int gw = C.bid * NWAVES + C.wave, NGW = C.G * NWAVES; int it = gw, base = 0;
    const CvtJob j0{P.in[ib + 0], WB + WB_MIX0, D, D, D, 1, 0};
    const CvtJob j1{P.in[ib + 1], WB + WB_MIX1, 256, 256, 256, 4, 0};
    const CvtJob j2{P.in[ib + 6], WB + WB_FFN0, D, FFE, FFE, NE, 1};
    const CvtJob j3{P.in[ib + 7], WB + WB_FFN0, D, FFE, FFE, NE, 2};
    const CvtJob j4{P.in[ib + 8], WB + WB_FFN1_MOE, FFE, D, D, NE, 0};
    CVT_RUN(j0); CVT_RUN(j1); CVT_RUN(j2); CVT_RUN(j3); CVT_RUN(j4);
}

__device__ __forceinline__ void prologue_misc(const Ctx& C, const Params& P) {
    const int gt = C.bid * 512 + C.tid, NT = C.G * 512;
    float* cosT = (float*)(P.ws + WS_ROPE); float* sinT = cosT + (size_t)M * 8;
    for (int i = gt; i < M * 8; i += NT) {
        const int m = i >> 3, j = i & 7;
        const float invf = (float)exp2(-(double)j * 0.125 * 18.931568569324174);
        const float ang = (float)P.positions[m] * invf;
        double rev = (double)ang * 0.15915494309189535; rev -= floor(rev);
        const float rf = (float)rev;
        cosT[i] = __builtin_amdgcn_cosf(rf); sinT[i] = __builtin_amdgcn_sinf(rf);
    }
    const float* x = P.in[0]; bf16_t* XB = (bf16_t*)(P.ws + WS_XB);
    for (int i = gt; i < M * D / 8; i += NT) {
        const f32x4 a = *(const f32x4*)(x + (size_t)i * 8), b = *(const f32x4*)(x + (size_t)i * 8 + 4);
        u32x4 w; w.x = pk2(a[0], a[1]); w.y = pk2(a[2], a[3]); w.z = pk2(b[0], b[1]); w.w = pk2(b[2], b[3]);
        *(u32x4*)(XB + (size_t)i * 8) = w;
    }
}

__device__ __forceinline__ void pool_phase(const Ctx& C, const bf16_t* U, bf16_t* Pd) {
    const int gt = C.bid * 512 + C.tid, NT = C.G * 512;
    for (int i = gt; i < M * (D / 8); i += NT) {
        const int m = i >> 7, ch = i & 127, t = m & (SEQ - 1), w = 2 << (ch >> 5);
        const int cnt = (t + 1 < w) ? (t + 1) : w;
        float s[8];
#pragma unroll
        for (int j = 0; j < 8; ++j) s[j] = 0.f;
        const bf16_t* p = U + (size_t)m * D + ch * 8;
        u32x4 self = *(const u32x4*)p;
        for (int k = 0; k < cnt; ++k) { const u32x4 v = *(const u32x4*)(p - (size_t)k * D);
            s[0] += bflo(v.x); s[1] += bfhi(v.x); s[2] += bflo(v.y); s[3] += bfhi(v.y); s[4] += bflo(v.z); s[5] += bfhi(v.z); s[6] += bflo(v.w); s[7] += bfhi(v.w); }
        const float inv = 1.0f / (float)cnt;
        u32x4 o;
        o.x = pk2(s[0] * inv - bflo(self.x), s[1] * inv - bfhi(self.x)); o.y = pk2(s[2] * inv - bflo(self.y), s[3] * inv - bfhi(self.y));
        o.z = pk2(s[4] * inv - bflo(self.z), s[5] * inv - bfhi(self.z)); o.w = pk2(s[6] * inv - bflo(self.w), s[7] * inv - bfhi(self.w));
        *(u32x4*)(Pd + (size_t)m * D + ch * 8) = o;
    }
}
__device__ __forceinline__ void conv_phase(const Ctx& C, const bf16_t* Bb, const bf16_t* Z, const float* cw, bf16_t* Gd) {
    const int gt = C.bid * 512 + C.tid, NT = C.G * 512;
    for (int i = gt; i < M * (D / 8); i += NT) {
        const int m = i >> 7, ch = i & 127, t = m & (SEQ - 1);
        const size_t off = (size_t)m * D + ch * 8;
        const u32x4 z0 = *(const u32x4*)(Z + off);
        u32x4 z1 = {0u, 0u, 0u, 0u}, z2 = {0u, 0u, 0u, 0u};
        if (t >= 1) z1 = *(const u32x4*)(Z + off - D);
        if (t >= 2) z2 = *(const u32x4*)(Z + off - 2 * D);
        const u32x4 bb = *(const u32x4*)(Bb + off);
        const f32x4 w0a = *(const f32x4*)(cw + ch * 8), w0b = *(const f32x4*)(cw + ch * 8 + 4);
        const f32x4 w1a = *(const f32x4*)(cw + D + ch * 8), w1b = *(const f32x4*)(cw + D + ch * 8 + 4);
        const f32x4 w2a = *(const f32x4*)(cw + 2 * D + ch * 8), w2b = *(const f32x4*)(cw + 2 * D + ch * 8 + 4);
        float r[8];
        r[0] = bflo(bb.x) * (w0a[0] * bflo(z0.x) + w1a[0] * bflo(z1.x) + w2a[0] * bflo(z2.x));
        r[1] = bfhi(bb.x) * (w0a[1] * bfhi(z0.x) + w1a[1] * bfhi(z1.x) + w2a[1] * bfhi(z2.x));
        r[2] = bflo(bb.y) * (w0a[2] * bflo(z0.y) + w1a[2] * bflo(z1.y) + w2a[2] * bflo(z2.y));
        r[3] = bfhi(bb.y) * (w0a[3] * bfhi(z0.y) + w1a[3] * bfhi(z1.y) + w2a[3] * bfhi(z2.y));
        r[4] = bflo(bb.z) * (w0b[0] * bflo(z0.z) + w1b[0] * bflo(z1.z) + w2b[0] * bflo(z2.z));
        r[5] = bfhi(bb.z) * (w0b[1] * bfhi(z0.z) + w1b[1] * bfhi(z1.z) + w2b[1] * bfhi(z2.z));
        r[6] = bflo(bb.w) * (w0b[2] * bflo(z0.w) + w1b[2] * bflo(z1.w) + w2b[2] * bflo(z2.w));
        r[7] = bfhi(bb.w) * (w0b[3] * bfhi(z0.w) + w1b[3] * bfhi(z1.w) + w2b[3] * bfhi(z2.w));
        u32x4 o; o.x = pk2(r[0], r[1]); o.y = pk2(r[2], r[3]); o.z = pk2(r[4], r[5]); o.w = pk2(r[6], r[7]);
        *(u32x4*)(Gd + off) = o;
    }
}

template <int MODE, bool ROUTER>
__device__ __forceinline__ void ln_phase(const Ctx& C, const Params& P, const float* PRE  , const float* XF  , const float* gam, const float* bet, float* outF, bf16_t* outB, const float* wrouter) {
    const bf16_t* Y = (const bf16_t*)(P.ws + WS_AUX + AX_Y);
    const int* POS = (const int*)(P.ws + WS_MISC + MS_POS);
    int* SEL = (int*)(P.ws + WS_MISC + MS_SEL); float* GATE = (float*)(P.ws + WS_MISC + MS_GATE); unsigned* WGCNT = (unsigned*)(P.ws + WS_MISC + MS_WGCNT);
    LAS float* wr_lds = (LAS float*)C.lds;
    LAS unsigned* cnt_lds = (LAS unsigned*)(C.lds + 32768);
    const f32x4* g4 = (const f32x4*)gam + C.lane; const f32x4* b4 = (const f32x4*)bet + C.lane;
    f32x4 gv[4], bv[4];
#pragma unroll
    for (int j = 0; j < 4; ++j) { gv[j] = g4[64 * j]; bv[j] = b4[64 * j]; }
    if (ROUTER) {
        for (int k = C.tid; k < D; k += 512) { const f32x4 a = *(const f32x4*)(wrouter + (size_t)k * 8), b = *(const f32x4*)(wrouter + (size_t)k * 8 + 4);
            wr_lds[0 * D + k] = a[0]; wr_lds[1 * D + k] = a[1]; wr_lds[2 * D + k] = a[2]; wr_lds[3 * D + k] = a[3];
            wr_lds[4 * D + k] = b[0]; wr_lds[5 * D + k] = b[1]; wr_lds[6 * D + k] = b[2]; wr_lds[7 * D + k] = b[3]; }
    }
    for (int tb = C.bid; tb < M / 64; tb += C.G) {
        if (ROUTER) { if (C.tid < 8) cnt_lds[C.tid] = 0u; __syncthreads(); }
        for (int i = 0; i < 8; ++i) {
            const int row = tb * 64 + C.wave * 8 + i;
            f32x4 v[4];
            if (MODE == 0) { const f32x4* p = (const f32x4*)(PRE + (size_t)row * D) + C.lane;
#pragma unroll
                for (int j = 0; j < 4; ++j) v[j] = p[64 * j];
            } else {
                const int p0 = POS[2 * row], p1 = POS[2 * row + 1];
                const f32x4* p = (const f32x4*)(XF + (size_t)row * D) + C.lane;
                const u32x2* y0 = (const u32x2*)(Y + (size_t)p0 * D) + C.lane; const u32x2* y1 = (const u32x2*)(Y + (size_t)p1 * D) + C.lane;
#pragma unroll
                for (int j = 0; j < 4; ++j) { const f32x4 xv = p[64 * j]; const u32x2 a = y0[64 * j], b = y1[64 * j];
                    v[j][0] = ALPHA * xv[0] + (bflo(a.x) + bflo(b.x)); v[j][1] = ALPHA * xv[1] + (bfhi(a.x) + bfhi(b.x));
                    v[j][2] = ALPHA * xv[2] + (bflo(a.y) + bflo(b.y)); v[j][3] = ALPHA * xv[3] + (bfhi(a.y) + bfhi(b.y)); }
            }
            float s = 0.f;
#pragma unroll
            for (int j = 0; j < 4; ++j) s += (v[j][0] + v[j][1]) + (v[j][2] + v[j][3]);
            const float mean = wave_sum(s) * (1.f / D); float s2 = 0.f;
#pragma unroll
            for (int j = 0; j < 4; ++j) { v[j] = v[j] - mean; s2 += (v[j][0] * v[j][0] + v[j][1] * v[j][1]) + (v[j][2] * v[j][2] + v[j][3] * v[j][3]); }
            const float rstd = 1.f / sqrtf(wave_sum(s2) * (1.f / D) + LN_EPS);
#pragma unroll
            for (int j = 0; j < 4; ++j) v[j] = v[j] * rstd * gv[j] + bv[j];
            f32x4* of = (f32x4*)(outF + (size_t)row * D) + C.lane;
#pragma unroll
            for (int j = 0; j < 4; ++j) of[64 * j] = v[j];
            if (outB) { u32x2* ob = (u32x2*)(outB + (size_t)row * D) + C.lane;
#pragma unroll
                for (int j = 0; j < 4; ++j) { u32x2 w; w.x = pk2(v[j][0], v[j][1]); w.y = pk2(v[j][2], v[j][3]); ob[64 * j] = w; } }
            if (ROUTER) {
                float lg[8];
#pragma unroll
                for (int e = 0; e < 8; ++e) { float a = 0.f;
#pragma unroll
                    for (int j = 0; j < 4; ++j) { const f32x4 w = *(const LAS f32x4*)(wr_lds + e * D + 256 * j + 4 * C.lane); a += (v[j][0] * w[0] + v[j][1] * w[1]) + (v[j][2] * w[2] + v[j][3] * w[3]); }
                    lg[e] = wave_sum(a); }
                int e0 = 0; float v0 = lg[0];
#pragma unroll
                for (int e = 1; e < 8; ++e) if (lg[e] > v0) { v0 = lg[e]; e0 = e; }
                int e1 = -1; float v1 = -3.0e38f;
#pragma unroll
                for (int e = 0; e < 8; ++e) if (e != e0 && lg[e] > v1) { v1 = lg[e]; e1 = e; }
                const float g1 = 1.0f / (1.0f + __expf(v0 - v1)), g0 = 1.0f - g1;
                if (C.lane == 0) { SEL[2 * row] = e0; SEL[2 * row + 1] = e1; GATE[2 * row] = g0; GATE[2 * row + 1] = g1;
                    atomicAdd((unsigned*)(cnt_lds + e0), 1u); atomicAdd((unsigned*)(cnt_lds + e1), 1u); }
            }
        }
        if (ROUTER) { __syncthreads(); if (C.tid < 8) WGCNT[tb * 8 + C.tid] = cnt_lds[C.tid]; __syncthreads(); }
    }
}

__device__ __forceinline__ void moe_gather_phase(const Ctx& C, const Params& P) {
    const int* SEL = (const int*)(P.ws + WS_MISC + MS_SEL); const float* GATE = (const float*)(P.ws + WS_MISC + MS_GATE); const unsigned* WGCNT = (const unsigned*)(P.ws + WS_MISC + MS_WGCNT);
    int* POS = (int*)(P.ws + WS_MISC + MS_POS); int* OFF = (int*)(P.ws + WS_MISC + MS_OFF); float* ROWGATE = (float*)(P.ws + WS_MISC + MS_ROWGATE);
    const bf16_t* XB = (const bf16_t*)(P.ws + WS_XB); bf16_t* XP = (bf16_t*)(P.ws + WS_AUX + AX_XPERM);
    LAS unsigned* part = (LAS unsigned*)C.lds;
    LAS int* tot = (LAS int*)(C.lds + 4096);
    LAS int* ppos = (LAS int*)(C.lds + 8192);
    for (int tb = C.bid; tb < M / 64; tb += C.G) {
        { const int e = C.tid & 7, q = C.tid >> 3; unsigned t = 0, bfr = 0;
#pragma unroll
          for (int k = 0; k < 4; ++k) { const int b2 = 4 * q + k; const unsigned c = WGCNT[b2 * 8 + e]; t += c; bfr += (b2 < tb) ? c : 0u; }
          part[q * 8 + e] = t; part[512 + q * 8 + e] = bfr; }
        __syncthreads();
        if (C.tid < 8) { unsigned t = 0, bfr = 0; for (int q = 0; q < 64; ++q) { t += part[q * 8 + C.tid]; bfr += part[512 + q * 8 + C.tid]; } tot[C.tid] = (int)t; tot[8 + C.tid] = (int)bfr; }
        __syncthreads();
        if (C.tid == 0) { int o = 0; for (int e = 0; e < 8; ++e) { tot[16 + e] = o; o += (tot[e] + 255) & ~255; } tot[24] = o; }
        __syncthreads();
        if (tb == 0 && C.tid < 9) OFF[C.tid] = tot[16 + C.tid];
        if (C.wave == 0) {
            const int row = tb * 64 + C.lane; const int e0 = SEL[2 * row], e1 = SEL[2 * row + 1];
            int p0 = 0, p1 = 0;
            const unsigned long long lt = (1ull << C.lane) - 1ull;
#pragma unroll
            for (int e = 0; e < 8; ++e) { const unsigned long long m0 = __ballot(e0 == e), m1 = __ballot(e1 == e);
                const int bs = tot[16 + e] + tot[8 + e]; const int n0 = __popcll(m0);
                if (e0 == e) p0 = bs + __popcll(m0 & lt);
                if (e1 == e) p1 = bs + n0 + __popcll(m1 & lt); }
            POS[2 * row] = p0; POS[2 * row + 1] = p1; ppos[2 * C.lane] = p0; ppos[2 * C.lane + 1] = p1;
            ROWGATE[p0] = GATE[2 * row]; ROWGATE[p1] = GATE[2 * row + 1];
        }
        __syncthreads();
        for (int k = 0; k < 16; ++k) { const int pr = C.wave * 16 + k; const int row = tb * 64 + (pr >> 1); const int dst = ppos[pr];
            const u32x4* s = (const u32x4*)(XB + (size_t)row * D) + C.lane; u32x4* d = (u32x4*)(XP + (size_t)dst * D) + C.lane;
            d[0] = s[0]; d[64] = s[64]; }
        for (int e = 0; e < 8; ++e) { const int ps = tot[16 + e] + tot[e], pe = tot[16 + e + 1];
            for (int r = ps + (tb * NWAVES + C.wave); r < pe; r += (M / 64) * NWAVES) { u32x4* d = (u32x4*)(XP + (size_t)r * D) + C.lane; d[0] = (u32x4){0u, 0u, 0u, 0u}; d[64] = (u32x4){0u, 0u, 0u, 0u}; if (C.lane == 0) ROWGATE[r] = 0.f; } }
        __syncthreads();
    }
}

__device__ __forceinline__ int crow(int r, int hi) { return (r & 3) + 8 * (r >> 2) + 4 * hi; }
__device__ __forceinline__ s16x4 vtr(const LAS unsigned char* p) { typedef short v4i16_t __attribute__((ext_vector_type(4))); return __builtin_bit_cast(s16x4, __builtin_amdgcn_ds_read_tr16_b64_v4i16((LAS v4i16_t*)p)); }
__device__ __forceinline__ void attn_unit(LAS unsigned char* wl  , const bf16_t* QKV, bf16_t* OG, float* LSE, int g, int dil, int b, int h, int r, int qb, int lane) {
    const int r32 = lane & 31, hi = lane >> 5, q0 = qb * 32;
    const bf16_t* base = QKV + (size_t)(b * SEQ + r) * QKVW + g * 3072 + h * 64;
    const size_t rs = (size_t)dil * QKVW;
    LAS float* wsf = (LAS float*)(wl + 4096);
    bf16x8 qr[4];
    { const bf16_t* qp = base + (size_t)(q0 + r32) * rs + 8 * hi;
#pragma unroll
      for (int d0 = 0; d0 < 4; ++d0) qr[d0] = *(const bf16x8*)(qp + 16 * d0); }
    f32x16 o0, o1;
#pragma unroll
    for (int i = 0; i < 16; ++i) { o0[i] = 0.f; o1[i] = 0.f; }
    float mrow = -INFINITY, lrow = 0.f;
    const int kt0 = qb >= 4 ? qb - 4 : 0;
    const int vb = ((lane >> 4) & 1) * 32 + (lane & 3) * 8 + (4 * hi + ((lane & 15) >> 2)) * 64;
    for (int kt = kt0; kt <= qb; ++kt) {
        bf16x8 kf[4]; u32x4 vv[4];
        { const bf16_t* kp = base + 1024 + (size_t)(32 * kt + r32) * rs + 8 * hi;
#pragma unroll
          for (int d0 = 0; d0 < 4; ++d0) kf[d0] = *(const bf16x8*)(kp + 16 * d0);
          const bf16_t* vp = base + 2048 + (size_t)(32 * kt + (lane >> 1)) * rs + 32 * (lane & 1);
#pragma unroll
          for (int c = 0; c < 4; ++c) vv[c] = *(const u32x4*)(vp + 8 * c); }
        f32x16 p;
#pragma unroll
        for (int i = 0; i < 16; ++i) p[i] = 0.f;
#pragma unroll
        for (int d0 = 0; d0 < 4; ++d0) p = __builtin_amdgcn_mfma_f32_32x32x16_bf16(kf[d0], qr[d0], p, 0, 0, 0);
        if (kt == qb || kt == qb - 4) {
            const int q = q0 + r32;
#pragma unroll
            for (int i = 0; i < 16; ++i) { const int key = 32 * kt + crow(i, hi); if (key > q || key < q - 128) p[i] = -INFINITY; }
        }
        float mx = p[0];
#pragma unroll
        for (int i = 1; i < 16; ++i) mx = fmaxf(mx, p[i]);
        mx = fmaxf(mx, __shfl_xor(mx, 32));
        const float mnew = fmaxf(mrow, mx);
        const float alpha = __builtin_amdgcn_exp2f(mrow - mnew);
        mrow = mnew;
        float ps = 0.f;
#pragma unroll
        for (int i = 0; i < 16; ++i) { p[i] = __builtin_amdgcn_exp2f(p[i] - mnew); ps += p[i]; }
        lrow = lrow * alpha + ps;
        { const int key = lane >> 1, blk = ((key >> 4) * 2 + (lane & 1)) * 1024 + (key & 15) * 64;
#pragma unroll
          for (int c = 0; c < 4; ++c) *(LAS u32x4*)(wl + blk + 16 * c) = vv[c];
          if (hi == 0) wsf[r32] = alpha; }
        LDS_WAIT(); asm volatile("" ::: "memory");
#pragma unroll
        for (int i = 0; i < 16; ++i) { const float a = wsf[crow(i, hi)]; o0[i] *= a; o1[i] *= a; }
        u32x4 pw0, pw1;
        pw0.x = cvt_pk_bf16(p[0], p[1]); pw0.y = cvt_pk_bf16(p[2], p[3]); pw0.z = cvt_pk_bf16(p[4], p[5]); pw0.w = cvt_pk_bf16(p[6], p[7]);
        pw1.x = cvt_pk_bf16(p[8], p[9]); pw1.y = cvt_pk_bf16(p[10], p[11]); pw1.z = cvt_pk_bf16(p[12], p[13]); pw1.w = cvt_pk_bf16(p[14], p[15]);
#pragma unroll
        for (int ks = 0; ks < 2; ++ks) {
            const bf16x8 pa = __builtin_bit_cast(bf16x8, ks == 0 ? pw0 : pw1);
            { const s16x4 lo = vtr(wl + (ks * 2 + 0) * 1024 + vb), hh = vtr(wl + (ks * 2 + 0) * 1024 + vb + 512);
              const bf16x8 vf = {lo[0], lo[1], lo[2], lo[3], hh[0], hh[1], hh[2], hh[3]};
              o0 = __builtin_amdgcn_mfma_f32_32x32x16_bf16(pa, vf, o0, 0, 0, 0); }
            { const s16x4 lo = vtr(wl + (ks * 2 + 1) * 1024 + vb), hh = vtr(wl + (ks * 2 + 1) * 1024 + vb + 512);
              const bf16x8 vf = {lo[0], lo[1], lo[2], lo[3], hh[0], hh[1], hh[2], hh[3]};
              o1 = __builtin_amdgcn_mfma_f32_32x32x16_bf16(pa, vf, o1, 0, 0, 0); }
        }
        LDS_WAIT(); asm volatile("" ::: "memory");
    }
    const float ltot = lrow + __shfl_xor(lrow, 32);
    if (hi == 0) { wsf[r32] = 1.0f / ltot;
        LSE[(size_t)(b * SEQ + (q0 + r32) * dil + r) * 16 + h] = mrow + __log2f(ltot); }
    LDS_WAIT(); asm volatile("" ::: "memory");
    LAS bf16_t* stg = (LAS bf16_t*)wl;
#pragma unroll
    for (int i = 0; i < 16; ++i) { const int orow = crow(i, hi); const float inv = wsf[orow];
        stg[orow * 64 + r32] = (bf16_t)f2bf(o0[i] * inv); stg[orow * 64 + 32 + r32] = (bf16_t)f2bf(o1[i] * inv); }
    LDS_WAIT(); asm volatile("" ::: "memory");
#pragma unroll
    for (int i = 0; i < 4; ++i) { const int row = i * 8 + (lane >> 3), ch = lane & 7; const u32x4 v = *(const LAS u32x4*)(stg + row * 64 + ch * 8);
        *(u32x4*)(OG + (size_t)(b * SEQ + (q0 + row) * dil + r) * D + h * 64 + ch * 8) = v; }
    LDS_WAIT(); asm volatile("" ::: "memory");
}
__device__ __forceinline__ void attn_phase(const Ctx& C, const Params& P) {
    const bf16_t* QKV = (const bf16_t*)(P.ws + WS_BIG + BG_QKV);
    LAS unsigned char* wl = C.lds + C.wave * 4608;
    const int gw = C.bid * NWAVES + C.wave, NGW = C.G * NWAVES;
    for (int i = 0; ; ++i) {
        const int uidx = i * NGW + gw; if (uidx >= 3 * 8192) break;
        const int g = uidx >> 13, j = uidx & 8191;
        const int dil = (g == 0) ? 1 : (g == 1 ? 4 : 16), lg = (g == 0) ? 6 : (g == 1 ? 4 : 2);
        const int nqb = 1 << lg, seq = j >> lg, qb = ((j & (nqb - 1)) + (i & 3) * (nqb >> 2)) & (nqb - 1);
        const int r = seq % dil, bh = seq / dil, h = bh & 15, b = bh >> 4;
        bf16_t* OG = (bf16_t*)(P.ws + WS_AUX + AX_OG) + (size_t)g * M * D; float* LSE = (float*)(P.ws + WS_AUX + AX_LSE) + (size_t)g * M * 16;
        attn_unit(wl, QKV, OG, LSE, g, dil, b, h, r, qb, C.lane);
    }
}
__device__ __forceinline__ void combine_phase(const Ctx& C, const Params& P) {
    const bf16_t* OG = (const bf16_t*)(P.ws + WS_AUX + AX_OG); const float* LSE = (const float*)(P.ws + WS_AUX + AX_LSE); bf16_t* ATT = (bf16_t*)(P.ws + WS_AUX + AX_ATT);
    const int gt = C.bid * 512 + C.tid, NT = C.G * 512;
    for (int i = gt; i < M * (D / 8); i += NT) {
        const int m = i >> 7, ch = i & 127, h = ch >> 3;
        const float l0 = LSE[(size_t)m * 16 + h], l1 = LSE[(size_t)(M + m) * 16 + h], l2 = LSE[(size_t)(2 * M + m) * 16 + h];
        const float mx = fmaxf(l0, fmaxf(l1, l2));
        float w0 = __builtin_amdgcn_exp2f(l0 - mx), w1 = __builtin_amdgcn_exp2f(l1 - mx), w2 = __builtin_amdgcn_exp2f(l2 - mx);
        const float inv = 1.0f / (w0 + w1 + w2); w0 *= inv; w1 *= inv; w2 *= inv;
        const size_t off = (size_t)m * D + ch * 8;
        const u32x4 a = *(const u32x4*)(OG + off), b = *(const u32x4*)(OG + (size_t)M * D + off), c = *(const u32x4*)(OG + (size_t)2 * M * D + off);
        u32x4 o;
        o.x = pk2(w0 * bflo(a.x) + w1 * bflo(b.x) + w2 * bflo(c.x), w0 * bfhi(a.x) + w1 * bfhi(b.x) + w2 * bfhi(c.x));
        o.y = pk2(w0 * bflo(a.y) + w1 * bflo(b.y) + w2 * bflo(c.y), w0 * bfhi(a.y) + w1 * bfhi(b.y) + w2 * bfhi(c.y));
        o.z = pk2(w0 * bflo(a.z) + w1 * bflo(b.z) + w2 * bflo(c.z), w0 * bfhi(a.z) + w1 * bfhi(b.z) + w2 * bfhi(c.z));
        o.w = pk2(w0 * bflo(a.w) + w1 * bflo(b.w) + w2 * bflo(c.w), w0 * bfhi(a.w) + w1 * bfhi(b.w) + w2 * bfhi(c.w));
        *(u32x4*)(ATT + off) = o;
    }
}


#if MK_CHECK
__device__ __forceinline__ unsigned hsh(unsigned x) { x ^= x >> 16; x *= 0x7feb352dU; x ^= x >> 15; x *= 0x846ca68bU; x ^= x >> 16; return x; }
__device__ __forceinline__ float rbf(float x) { return bf2f(f2bf(x)); }
__device__ __forceinline__ void chk_acc(const Params& P, int p, float e2, float r2) {
    e2 = wave_sum(e2); r2 = wave_sum(r2);
    if ((threadIdx.x & 63) == 0) { float* w = (float*)(P.ws + WS_CTL) + CW_CHK + 2 * p; atomicAdd(w, e2); atomicAdd(w + 1, r2); }
}
#define CHK_BEGIN(NS) const int gt = C.bid * 512 + C.tid, NT = C.G * 512; float e2 = 0.f, r2 = 0.f; for (int s_ = gt; s_ < (NS); s_ += NT) { const unsigned h1 = hsh(2u * (unsigned)s_ + 0x9e3779b9u * (unsigned)(p + 1)), h2 = hsh(h1 + 0x85ebca6bu); (void)h2;
#define CHK_CMP(got, ref) do { const float _g = (got), _r = (ref); const float _d = _g - _r; e2 += (_d == _d) ? _d * _d : 1e30f; r2 += _r * _r; } while (0)
#define CHK_END() } chk_acc(P, p, e2, r2);
__device__ __forceinline__ float dot_aw(const bf16_t* a, const float* w, int K, int ldw) { float s = 0.f; for (int k = 0; k < K; ++k) s += bf2f(a[k]) * rbf(w[(size_t)k * ldw]); return s; }

__device__ __forceinline__ void chk_gemm_bf16(const Ctx& C, const Params& P, int p, const bf16_t* A, int lda, const float* W, int ldw, int K, const bf16_t* O, int ldo, int N) {
    CHK_BEGIN(16384) const int m = h1 % M, n = h2 % N; CHK_CMP(bf2f(O[(size_t)m * ldo + n]), dot_aw(A + (size_t)m * lda, W + n, K, ldw)); CHK_END()
}
__device__ __forceinline__ void chk_gemm_pre(const Ctx& C, const Params& P, int p, const bf16_t* A, int lda, int K, int grouped, const float* W, int ldw, const float* X, const float* scale, const float* O) {
    CHK_BEGIN(16384) const int m = h1 % M, n = h2 % D; const int g = n >> 8;
    const float d = grouped ? dot_aw(A + (size_t)m * lda + g * 256, W + (size_t)g * 256 * 256 + (n & 255), 256, 256) : dot_aw(A + (size_t)m * lda, W + n, K, ldw);
    CHK_CMP(O[(size_t)m * D + n], ALPHA * X[(size_t)m * D + n] + (scale ? scale[n] : 1.f) * d); CHK_END()
}
__device__ __forceinline__ void chk_swiglu(const Ctx& C, const Params& P, int p, const bf16_t* A, const float* Wg, const float* Wu, const bf16_t* O) {
    CHK_BEGIN(16384) const int m = h1 % M, n = h2 % FF; const float a = dot_aw(A + (size_t)m * D, Wg + n, D, FF), b = dot_aw(A + (size_t)m * D, Wu + n, D, FF);
    CHK_CMP(bf2f(O[(size_t)m * FF + n]), (a / (1.f + expf(-a))) * b); CHK_END()
}
__device__ __forceinline__ void chk_ln(const Ctx& C, const Params& P, int p, const float* PREb, const float* gam, const float* bet, const float* OF, const bf16_t* OB) {
    CHK_BEGIN(4096) const int m = h1 % M, n = h2 % D; const float* r = PREb + (size_t)m * D; float s = 0.f; for (int k = 0; k < D; ++k) s += r[k]; const float mean = s / D; float q = 0.f; for (int k = 0; k < D; ++k) { const float d = r[k] - mean; q += d * d; }
    const float ref = (r[n] - mean) / sqrtf(q / D + LN_EPS) * gam[n] + bet[n]; CHK_CMP(OF[(size_t)m * D + n], ref); if (OB) CHK_CMP(bf2f(OB[(size_t)m * D + n]), ref); CHK_END()
}
__device__ __forceinline__ void chk_pool(const Ctx& C, const Params& P, int p, const bf16_t* U, const bf16_t* Pd) {
    CHK_BEGIN(32768) const int m = h1 % M, n = h2 % D, t = m & (SEQ - 1), w = 2 << (n >> 8); const int cnt = t + 1 < w ? t + 1 : w; float s = 0.f; for (int k = 0; k < cnt; ++k) s += bf2f(U[(size_t)(m - k) * D + n]);
    CHK_CMP(bf2f(Pd[(size_t)m * D + n]), s / cnt - bf2f(U[(size_t)m * D + n])); CHK_END()
}
__device__ __forceinline__ void chk_rope_xb(const Ctx& C, const Params& P, int p) {
    const float* cosT = (const float*)(P.ws + WS_ROPE); const float* sinT = cosT + (size_t)M * 8; const bf16_t* XB = (const bf16_t*)(P.ws + WS_XB);
    CHK_BEGIN(32768) const int m = h1 % M, j = h2 & 7, n = h2 % D; const float invf = powf(500000.0f, -(float)j / 8.0f); const double ang = (double)((float)P.positions[m] * invf);
    CHK_CMP(cosT[m * 8 + j], (float)cos(ang)); CHK_CMP(sinT[m * 8 + j], (float)sin(ang)); CHK_CMP(bf2f(XB[(size_t)m * D + n]), P.in[0][(size_t)m * D + n]); CHK_END()
}
__device__ __forceinline__ void chk_qkv(const Ctx& C, const Params& P, int p, const bf16_t* A, const float* W, const bf16_t* O) {
    const float* cosT = (const float*)(P.ws + WS_ROPE); const float* sinT = cosT + (size_t)M * 8;
    CHK_BEGIN(16384) const int m = h1 % M, c = h2 % QKVW, kind = (c % 3072) >> 10, d = c & 63; const bf16_t* a = A + (size_t)m * D; float ref;
    if (kind < 2 && d < 16) { const int c1 = c - d + (d & 7), c2 = c1 + 8; const float r1 = dot_aw(a, W + c1, D, QKVW), r2 = dot_aw(a, W + c2, D, QKVW), cs = cosT[m * 8 + (d & 7)], sn = sinT[m * 8 + (d & 7)];
        ref = d < 8 ? r1 * cs - r2 * sn : r1 * sn + r2 * cs; } else ref = dot_aw(a, W + c, D, QKVW);
    if (kind == 0) ref *= QSCALE; CHK_CMP(bf2f(O[(size_t)m * QKVW + c]), ref); CHK_END()
}
__device__ __forceinline__ void chk_attn(const Ctx& C, const Params& P, int p) {
    const bf16_t* QKV = (const bf16_t*)(P.ws + WS_BIG + BG_QKV); const bf16_t* OG = (const bf16_t*)(P.ws + WS_AUX + AX_OG); const float* LSE = (const float*)(P.ws + WS_AUX + AX_LSE);
    CHK_BEGIN(8192) const int m = h1 % M, g = (h1 >> 16) % 3, h = h2 & 15, d = (h2 >> 4) & 63, dil = g == 0 ? 1 : (g == 1 ? 4 : 16), t = m & (SEQ - 1);
    const bf16_t* q = QKV + (size_t)m * QKVW + g * 3072 + h * 64; float mx = -INFINITY;
    for (int j = 0; j <= 128; ++j) { const int tk = t - j * dil; if (tk < 0) break; const bf16_t* k = QKV + (size_t)(m - j * dil) * QKVW + g * 3072 + 1024 + h * 64; float sc = 0.f; for (int e = 0; e < 64; ++e) sc += bf2f(q[e]) * bf2f(k[e]); mx = fmaxf(mx, sc); }
    float l = 0.f, o = 0.f;
    for (int j = 0; j <= 128; ++j) { const int tk = t - j * dil; if (tk < 0) break; const bf16_t* k = QKV + (size_t)(m - j * dil) * QKVW + g * 3072 + 1024 + h * 64; float sc = 0.f; for (int e = 0; e < 64; ++e) sc += bf2f(q[e]) * bf2f(k[e]);
        const float w = exp2f(sc - mx); l += w; o += w * bf2f(k[1024 + d]); }
    CHK_CMP(bf2f(OG[((size_t)g * M + m) * D + h * 64 + d]), o / l); CHK_CMP(LSE[((size_t)g * M + m) * 16 + h], mx + log2f(l)); CHK_END()
}
__device__ __forceinline__ void chk_combine(const Ctx& C, const Params& P, int p) {
    const bf16_t* OG = (const bf16_t*)(P.ws + WS_AUX + AX_OG); const float* LSE = (const float*)(P.ws + WS_AUX + AX_LSE); const bf16_t* ATT = (const bf16_t*)(P.ws + WS_AUX + AX_ATT);
    CHK_BEGIN(32768) const int m = h1 % M, n = h2 % D, h = n >> 6; float l[3], mx = -INFINITY; for (int g = 0; g < 3; ++g) { l[g] = LSE[((size_t)g * M + m) * 16 + h]; mx = fmaxf(mx, l[g]); }
    float sw = 0.f, o = 0.f; for (int g = 0; g < 3; ++g) { const float w = exp2f(l[g] - mx); sw += w; o += w * bf2f(OG[((size_t)g * M + m) * D + n]); }
    CHK_CMP(bf2f(ATT[(size_t)m * D + n]), o / sw); CHK_END()
}
__device__ __forceinline__ void chk_router(const Ctx& C, const Params& P, int p, const float* XFn, const float* Wr) {
    const int* SEL = (const int*)(P.ws + WS_MISC + MS_SEL); const float* GATE = (const float*)(P.ws + WS_MISC + MS_GATE);
    CHK_BEGIN(4096) const int m = h1 % M; float lg[8]; for (int e = 0; e < 8; ++e) lg[e] = 0.f; for (int k = 0; k < D; ++k) { const float xv = XFn[(size_t)m * D + k]; for (int e = 0; e < 8; ++e) lg[e] += xv * Wr[k * 8 + e]; }
    const int e0 = SEL[2 * m], e1 = SEL[2 * m + 1]; float bad = 0.f; if (e0 == e1 || e0 < 0 || e0 > 7 || e1 < 0 || e1 > 7) bad = 1.f; else { for (int e = 0; e < 8; ++e) { if (e != e0 && lg[e] > lg[e0] + 1e-3f) bad = 1.f; if (e != e0 && e != e1 && lg[e] > lg[e1] + 1e-3f) bad = 1.f; }
        const float g1 = 1.f / (1.f + expf(lg[e0] - lg[e1])); if (fabsf(GATE[2 * m + 1] - g1) > 2e-3f || fabsf(GATE[2 * m] - (1.f - g1)) > 2e-3f) bad = 1.f; }
    CHK_CMP(bad, 0.f); r2 += 1.f; CHK_END()
}
__device__ __forceinline__ void chk_gather(const Ctx& C, const Params& P, int p) {
    const int* SEL = (const int*)(P.ws + WS_MISC + MS_SEL); const float* GATE = (const float*)(P.ws + WS_MISC + MS_GATE); const int* POS = (const int*)(P.ws + WS_MISC + MS_POS); const int* OFF = (const int*)(P.ws + WS_MISC + MS_OFF);
    const float* ROWGATE = (const float*)(P.ws + WS_MISC + MS_ROWGATE); const bf16_t* XB = (const bf16_t*)(P.ws + WS_XB); const bf16_t* XP = (const bf16_t*)(P.ws + WS_AUX + AX_XPERM);
    CHK_BEGIN(32768) const int m = h1 % M, sl = (h1 >> 20) & 1, n = h2 % D, e = SEL[2 * m + sl], pos = POS[2 * m + sl]; float bad = 0.f;
    if (pos < OFF[e] || pos >= OFF[e + 1] || (OFF[e] & 255) || OFF[8] > MOE_ROWS_MAX || OFF[8] < 32768) bad = 1.f; else { if (XP[(size_t)pos * D + n] != XB[(size_t)m * D + n]) bad = 1.f; if (ROWGATE[pos] != GATE[2 * m + sl]) bad = 1.f; }
    CHK_CMP(bad, 0.f); r2 += 1.f; CHK_END()
}
__device__ __forceinline__ void chk_moe_up(const Ctx& C, const Params& P, int p, const float* Wg, const float* Wu) {
    const int* SEL = (const int*)(P.ws + WS_MISC + MS_SEL); const int* POS = (const int*)(P.ws + WS_MISC + MS_POS); const bf16_t* XP = (const bf16_t*)(P.ws + WS_AUX + AX_XPERM); const bf16_t* H = (const bf16_t*)(P.ws + WS_BIG + BG_HID);
    CHK_BEGIN(16384) const int m = h1 % M, sl = (h1 >> 20) & 1, n = h2 % FFE, e = SEL[2 * m + sl] & 7, pos = POS[2 * m + sl]; const bf16_t* a = XP + (size_t)pos * D;
    const float x = dot_aw(a, Wg + (size_t)e * D * FFE + n, D, FFE), y = dot_aw(a, Wu + (size_t)e * D * FFE + n, D, FFE); CHK_CMP(bf2f(H[(size_t)pos * FFE + n]), (x / (1.f + expf(-x))) * y); CHK_END()
}
__device__ __forceinline__ void chk_moe_down(const Ctx& C, const Params& P, int p, const float* Wd) {
    const int* SEL = (const int*)(P.ws + WS_MISC + MS_SEL); const int* POS = (const int*)(P.ws + WS_MISC + MS_POS); const float* GATE = (const float*)(P.ws + WS_MISC + MS_GATE); const bf16_t* H = (const bf16_t*)(P.ws + WS_BIG + BG_HID); const bf16_t* Y = (const bf16_t*)(P.ws + WS_AUX + AX_Y);
    CHK_BEGIN(16384) const int m = h1 % M, sl = (h1 >> 20) & 1, n = h2 % D, e = SEL[2 * m + sl] & 7, pos = POS[2 * m + sl];
    CHK_CMP(bf2f(Y[(size_t)pos * D + n]), GATE[2 * m + sl] * dot_aw(H + (size_t)pos * FFE, Wd + (size_t)e * FFE * D + n, FFE, D)); CHK_END()
}
__device__ __forceinline__ void chk_ln_moe(const Ctx& C, const Params& P, int p, const float* RS, const float* gam, const float* bet, const float* OF, const bf16_t* OB) {
    const int* POS = (const int*)(P.ws + WS_MISC + MS_POS); const bf16_t* Y = (const bf16_t*)(P.ws + WS_AUX + AX_Y);
    CHK_BEGIN(4096) const int m = h1 % M, n = h2 % D; const float* r = RS + (size_t)m * D; const bf16_t* y0 = Y + (size_t)POS[2 * m] * D; const bf16_t* y1 = Y + (size_t)POS[2 * m + 1] * D;
    float s = 0.f; for (int k = 0; k < D; ++k) s += ALPHA * r[k] + bf2f(y0[k]) + bf2f(y1[k]); const float mean = s / D; float q = 0.f; for (int k = 0; k < D; ++k) { const float d = ALPHA * r[k] + bf2f(y0[k]) + bf2f(y1[k]) - mean; q += d * d; }
    const float ref = (ALPHA * r[n] + bf2f(y0[n]) + bf2f(y1[n]) - mean) / sqrtf(q / D + LN_EPS) * gam[n] + bet[n]; CHK_CMP(OF[(size_t)m * D + n], ref); if (OB) CHK_CMP(bf2f(OB[(size_t)m * D + n]), ref); CHK_END()
}
__device__ __forceinline__ void chk_convin(const Ctx& C, const Params& P, int p, const bf16_t* A, const float* W, const bf16_t* Bb, const bf16_t* Z) {
    CHK_BEGIN(16384) const int m = h1 % M, n = h2 % D; const bf16_t* a = A + (size_t)m * D;
    if (h1 & 0x100000) CHK_CMP(bf2f(Bb[(size_t)m * D + n]), dot_aw(a, W + n, D, 3 * D)); else CHK_CMP(bf2f(Z[(size_t)m * D + n]), dot_aw(a, W + D + n, D, 3 * D) * dot_aw(a, W + 2 * D + n, D, 3 * D)); CHK_END()
}
__device__ __forceinline__ void chk_conv(const Ctx& C, const Params& P, int p, const bf16_t* Bb, const bf16_t* Z, const float* cw, const bf16_t* Gd) {
    CHK_BEGIN(32768) const int m = h1 % M, n = h2 % D, t = m & (SEQ - 1); float s = 0.f; for (int j = 0; j < 3; ++j) if (t - j >= 0) s += cw[j * D + n] * bf2f(Z[(size_t)(m - j) * D + n]);
    CHK_CMP(bf2f(Gd[(size_t)m * D + n]), bf2f(Bb[(size_t)m * D + n]) * s); CHK_END()
}
#endif

constexpr int NPHASE = 32;
constexpr int SMUL = MK_CHECK ? 2 : 1;
constexpr int NSTEPS = NPHASE * SMUL + (MK_CHECK ? 1 : 0);

__global__ void __launch_bounds__(NWAVES * 64, 2) hybrid_fwd(Params P) {
    extern __shared__ __attribute__((aligned(16))) unsigned char lds_raw[];
    Ctx C; C.lds = (LAS unsigned char*)lds_raw; C.tid = threadIdx.x; C.lane = C.tid & 63; C.wave = __builtin_amdgcn_readfirstlane(C.tid >> 6); C.G = gridDim.x; C.bid = blockIdx.x;
    volatile LAS unsigned* MISCW = (volatile LAS unsigned*)(C.lds + MISC_OFF);
    unsigned* ctl = (unsigned*)(P.ws + WS_CTL);
    for (int u = C.tid; u < (LDS_BYTES - LDSCTL_OFF) / 4; u += NWAVES * 64) ((LAS unsigned*)(C.lds + LDSCTL_OFF))[u] = 0u;
    __syncthreads();
    XcdBarrier bar; bar.bar = ctl + CW_BAR; bar.x = 0; bar.st = nullptr;
    if (!MK_PER_PHASE) bar = xcd_barrier_post(ctl + CW_BAR, MISCW + 8);
    const int lo = P.step_lo, hi = P.step_hi;
#define IN(k) (lo <= (k) && (k) < hi)
#define SEAM(k) do { if (IN(k) && IN((k) + 1)) { if (MK_PER_PHASE) { if (C.tid == 0) __hip_atomic_store(ctl + 1, 0xBADu, __ATOMIC_RELAXED, __HIP_MEMORY_SCOPE_AGENT); } else xcd_barrier(bar); } } while (0)
#if MK_CHECK
#define CHECK(p, stmt) do { if (IN(2 * (p) + 1)) { stmt; } SEAM(2 * (p) + 1); } while (0)
#else
#define CHECK(p, stmt) do { } while (0)
#endif
#define PH(p) (SMUL * (p))

    unsigned char* ws = P.ws;
    bf16_t* WB = (bf16_t*)(ws + WS_WB);
    float* XF = (float*)(ws + WS_XF); float* PRE = (float*)(ws + WS_PRE); bf16_t* XB = (bf16_t*)(ws + WS_XB);
    bf16_t* BIG = (bf16_t*)(ws + WS_BIG);
    bf16_t* Ub = (bf16_t*)(ws + WS_BIG + BG_U); bf16_t* Pb = (bf16_t*)(ws + WS_BIG + BG_P); bf16_t* Gb = (bf16_t*)(ws + WS_BIG + BG_G); bf16_t* HID = (bf16_t*)(ws + WS_BIG + BG_HID);
    bf16_t* ATT = (bf16_t*)(ws + WS_AUX + AX_ATT); bf16_t* XP = (bf16_t*)(ws + WS_AUX + AX_XPERM); bf16_t* Yb = (bf16_t*)(ws + WS_AUX + AX_Y);
    const float* cosT = (const float*)(ws + WS_ROPE); const float* sinT = cosT + (size_t)M * 8;
    const float* ROWGATE = (const float*)(ws + WS_MISC + MS_ROWGATE); const int* OFFT = (const int*)(ws + WS_MISC + MS_OFF);
    const int bx = (int)blockIdx.x;

    if (IN(PH(0))) { prologue_misc(C, P); convert_pool_ffn(C, P, 2); } SEAM(PH(0));
    CHECK(0, chk_rope_xb(C, P, 0));

    if (IN(PH(1))) { pg8::Gemm g{XB, WB + WB_MIX0, D, D, D}; pg8::StaticOrder S; S.init(M / 256, D / 256, C.G, bx); pg8::EpiBf16 E{Ub, D};
        pg8::gemm_phase<pg8::EpiBf16, pg8::StaticOrder>(C.lds, g, S, E); } SEAM(PH(1));
    CHECK(1, chk_gemm_bf16(C, P, 1, XB, D, P.in[2], D, D, Ub, D, D));
    if (IN(PH(2))) { pool_phase(C, Ub, Pb); } SEAM(PH(2));
    CHECK(2, chk_pool(C, P, 2, Ub, Pb));
    if (IN(PH(3))) { pg8::Gemm g{Pb, WB + WB_MIX1, D, 256, 256}; pg8::StaticOrder S; S.init(M / 256, 4, C.G, bx, 512u); pg8::EpiPre E{P.in[0], PRE, P.in[4]};
        pg8::gemm_phase<pg8::EpiPre, pg8::StaticOrder>(C.lds, g, S, E); } SEAM(PH(3));
    CHECK(3, chk_gemm_pre(C, P, 3, Pb, D, 256, 1, P.in[3], 256, P.in[0], P.in[4], PRE));
    if (IN(PH(4))) { ln_phase<0, false>(C, P, PRE, nullptr, P.in[5], P.in[6], XF, XB, nullptr); } SEAM(PH(4));
    CHECK(4, chk_ln(C, P, 4, PRE, P.in[5], P.in[6], XF, XB));
    if (IN(PH(5))) { pg8::Gemm g{XB, WB + WB_FFN0, D, D, D}; pg8::StaticOrder S; S.init(M / 256, 2 * FF / 256, C.G, bx); pg8::EpiSwiGLU E{HID, FF};
        pg8::gemm_phase<pg8::EpiSwiGLU, pg8::StaticOrder>(C.lds, g, S, E); } SEAM(PH(5));
    CHECK(5, chk_swiglu(C, P, 5, XB, P.in[7], P.in[8], HID));
    if (IN(PH(6))) { pg8::Gemm g{HID, WB + WB_FFN1_DENSE, FF, FF, FF}; pg8::StaticOrder S; S.init(M / 256, D / 256, C.G, bx); pg8::EpiPre E{XF, PRE, nullptr};
        pg8::gemm_phase<pg8::EpiPre, pg8::StaticOrder>(C.lds, g, S, E); } SEAM(PH(6));
    CHECK(6, chk_gemm_pre(C, P, 6, HID, FF, FF, 0, P.in[9], D, XF, nullptr, PRE));
    if (IN(PH(7))) { ln_phase<0, false>(C, P, PRE, nullptr, P.in[10], P.in[11], XF, XB, nullptr); __syncthreads(); convert_attn_moe(C, P, 12); } SEAM(PH(7));
    CHECK(7, chk_ln(C, P, 7, PRE, P.in[10], P.in[11], XF, XB));

    if (IN(PH(8))) { pg8::Gemm g{XB, WB + WB_MIX0, D, D, D}; pg8::StaticOrder S; S.init(M / 256, QKVW / 256, C.G, bx); pg8::EpiQKV E{BIG, cosT, sinT};
        pg8::gemm_phase<pg8::EpiQKV, pg8::StaticOrder>(C.lds, g, S, E); } SEAM(PH(8));
    CHECK(8, chk_qkv(C, P, 8, XB, P.in[12], BIG));
    if (IN(PH(9))) { attn_phase(C, P); } SEAM(PH(9));
    CHECK(9, chk_attn(C, P, 9));
    if (IN(PH(10))) { combine_phase(C, P); } SEAM(PH(10));
    CHECK(10, chk_combine(C, P, 10));
    if (IN(PH(11))) { pg8::Gemm g{ATT, WB + WB_MIX1, D, D, D}; pg8::StaticOrder S; S.init(M / 256, D / 256, C.G, bx); pg8::EpiPre E{XF, PRE, nullptr};
        pg8::gemm_phase<pg8::EpiPre, pg8::StaticOrder>(C.lds, g, S, E); } SEAM(PH(11));
    CHECK(11, chk_gemm_pre(C, P, 11, ATT, D, D, 0, P.in[13], D, XF, nullptr, PRE));
    if (IN(PH(12))) { ln_phase<0, true>(C, P, PRE, nullptr, P.in[14], P.in[15], XF, XB, P.in[16]); } SEAM(PH(12));
    CHECK(12, { chk_ln(C, P, 12, PRE, P.in[14], P.in[15], XF, XB); chk_router(C, P, 12, XF, P.in[16]); });
    if (IN(PH(13))) { moe_gather_phase(C, P); } SEAM(PH(13));
    CHECK(13, chk_gather(C, P, 13));
    if (IN(PH(14))) { pg8::Gemm g{XP, WB + WB_FFN0, D, D, D}; pg8::MoeOrder S; S.so.init(OFFT[8] / 256, 2 * FFE / 256, C.G, bx);
        S.o1 = OFFT[1]; S.o2 = OFFT[2]; S.o3 = OFFT[3]; S.o4 = OFFT[4]; S.o5 = OFFT[5]; S.o6 = OFFT[6]; S.o7 = OFFT[7]; S.estride = 2u * FFE * D * 2u;
        pg8::EpiSwiGLU E{HID, FFE}; pg8::gemm_phase<pg8::EpiSwiGLU, pg8::MoeOrder>(C.lds, g, S, E); } SEAM(PH(14));
    CHECK(14, chk_moe_up(C, P, 14, P.in[17], P.in[18]));
    if (IN(PH(15))) { pg8::Gemm g{HID, WB + WB_FFN1_MOE, FFE, FFE, FFE}; pg8::MoeOrder S; S.so.init(OFFT[8] / 256, D / 256, C.G, bx);
        S.o1 = OFFT[1]; S.o2 = OFFT[2]; S.o3 = OFFT[3]; S.o4 = OFFT[4]; S.o5 = OFFT[5]; S.o6 = OFFT[6]; S.o7 = OFFT[7]; S.estride = (unsigned)D * FFE * 2u;
        pg8::EpiMoeDown E{Yb, ROWGATE}; pg8::gemm_phase<pg8::EpiMoeDown, pg8::MoeOrder>(C.lds, g, S, E); } SEAM(PH(15));
    CHECK(15, chk_moe_down(C, P, 15, P.in[19]));
    if (IN(PH(16))) { ln_phase<1, false>(C, P, nullptr, XF, P.in[20], P.in[21], PRE, XB, nullptr); __syncthreads(); convert_conv_ffn(C, P, 22); } SEAM(PH(16));
    CHECK(16, chk_ln_moe(C, P, 16, XF, P.in[20], P.in[21], PRE, XB));

    if (IN(PH(17))) { pg8::Gemm g{XB, WB + WB_MIX0, D, D, D}; pg8::StaticOrder S; S.init(M / 256, 3 * D / 256, C.G, bx); pg8::EpiConvIn E{Ub, Pb};
        pg8::gemm_phase<pg8::EpiConvIn, pg8::StaticOrder>(C.lds, g, S, E); } SEAM(PH(17));
    CHECK(17, chk_convin(C, P, 17, XB, P.in[22], Ub, Pb));
    if (IN(PH(18))) { conv_phase(C, Ub, Pb, P.in[23], Gb); } SEAM(PH(18));
    CHECK(18, chk_conv(C, P, 18, Ub, Pb, P.in[23], Gb));
    if (IN(PH(19))) { pg8::Gemm g{Gb, WB + WB_MIX1, D, D, D}; pg8::StaticOrder S; S.init(M / 256, D / 256, C.G, bx); pg8::EpiPre E{PRE, XF, nullptr};
        pg8::gemm_phase<pg8::EpiPre, pg8::StaticOrder>(C.lds, g, S, E); } SEAM(PH(19));
    CHECK(19, chk_gemm_pre(C, P, 19, Gb, D, D, 0, P.in[24], D, PRE, nullptr, XF));
    if (IN(PH(20))) { ln_phase<0, false>(C, P, XF, nullptr, P.in[25], P.in[26], PRE, XB, nullptr); } SEAM(PH(20));
    CHECK(20, chk_ln(C, P, 20, XF, P.in[25], P.in[26], PRE, XB));
    if (IN(PH(21))) { pg8::Gemm g{XB, WB + WB_FFN0, D, D, D}; pg8::StaticOrder S; S.init(M / 256, 2 * FF / 256, C.G, bx); pg8::EpiSwiGLU E{HID, FF};
        pg8::gemm_phase<pg8::EpiSwiGLU, pg8::StaticOrder>(C.lds, g, S, E); } SEAM(PH(21));
    CHECK(21, chk_swiglu(C, P, 21, XB, P.in[27], P.in[28], HID));
    if (IN(PH(22))) { pg8::Gemm g{HID, WB + WB_FFN1_DENSE, FF, FF, FF}; pg8::StaticOrder S; S.init(M / 256, D / 256, C.G, bx); pg8::EpiPre E{PRE, XF, nullptr};
        pg8::gemm_phase<pg8::EpiPre, pg8::StaticOrder>(C.lds, g, S, E); } SEAM(PH(22));
    CHECK(22, chk_gemm_pre(C, P, 22, HID, FF, FF, 0, P.in[29], D, PRE, nullptr, XF));
    if (IN(PH(23))) { ln_phase<0, false>(C, P, XF, nullptr, P.in[30], P.in[31], PRE, XB, nullptr); __syncthreads(); convert_pool_moe(C, P, 32); } SEAM(PH(23));
    CHECK(23, chk_ln(C, P, 23, XF, P.in[30], P.in[31], PRE, XB));

    if (IN(PH(24))) { pg8::Gemm g{XB, WB + WB_MIX0, D, D, D}; pg8::StaticOrder S; S.init(M / 256, D / 256, C.G, bx); pg8::EpiBf16 E{Ub, D};
        pg8::gemm_phase<pg8::EpiBf16, pg8::StaticOrder>(C.lds, g, S, E); } SEAM(PH(24));
    CHECK(24, chk_gemm_bf16(C, P, 24, XB, D, P.in[32], D, D, Ub, D, D));
    if (IN(PH(25))) { pool_phase(C, Ub, Pb); } SEAM(PH(25));
    CHECK(25, chk_pool(C, P, 25, Ub, Pb));
    if (IN(PH(26))) { pg8::Gemm g{Pb, WB + WB_MIX1, D, 256, 256}; pg8::StaticOrder S; S.init(M / 256, 4, C.G, bx, 512u); pg8::EpiPre E{PRE, XF, P.in[34]};
        pg8::gemm_phase<pg8::EpiPre, pg8::StaticOrder>(C.lds, g, S, E); } SEAM(PH(26));
    CHECK(26, chk_gemm_pre(C, P, 26, Pb, D, 256, 1, P.in[33], 256, PRE, P.in[34], XF));
    if (IN(PH(27))) { ln_phase<0, true>(C, P, XF, nullptr, P.in[35], P.in[36], PRE, XB, P.in[37]); } SEAM(PH(27));
    CHECK(27, { chk_ln(C, P, 27, XF, P.in[35], P.in[36], PRE, XB); chk_router(C, P, 27, PRE, P.in[37]); });
    if (IN(PH(28))) { moe_gather_phase(C, P); } SEAM(PH(28));
    CHECK(28, chk_gather(C, P, 28));
    if (IN(PH(29))) { pg8::Gemm g{XP, WB + WB_FFN0, D, D, D}; pg8::MoeOrder S; S.so.init(OFFT[8] / 256, 2 * FFE / 256, C.G, bx);
        S.o1 = OFFT[1]; S.o2 = OFFT[2]; S.o3 = OFFT[3]; S.o4 = OFFT[4]; S.o5 = OFFT[5]; S.o6 = OFFT[6]; S.o7 = OFFT[7]; S.estride = 2u * FFE * D * 2u;
        pg8::EpiSwiGLU E{HID, FFE}; pg8::gemm_phase<pg8::EpiSwiGLU, pg8::MoeOrder>(C.lds, g, S, E); } SEAM(PH(29));
    CHECK(29, chk_moe_up(C, P, 29, P.in[38], P.in[39]));
    if (IN(PH(30))) { pg8::Gemm g{HID, WB + WB_FFN1_MOE, FFE, FFE, FFE}; pg8::MoeOrder S; S.so.init(OFFT[8] / 256, D / 256, C.G, bx);
        S.o1 = OFFT[1]; S.o2 = OFFT[2]; S.o3 = OFFT[3]; S.o4 = OFFT[4]; S.o5 = OFFT[5]; S.o6 = OFFT[6]; S.o7 = OFFT[7]; S.estride = (unsigned)D * FFE * 2u;
        pg8::EpiMoeDown E{Yb, ROWGATE}; pg8::gemm_phase<pg8::EpiMoeDown, pg8::MoeOrder>(C.lds, g, S, E); } SEAM(PH(30));
    CHECK(30, chk_moe_down(C, P, 30, P.in[40]));
    if (IN(PH(31))) { ln_phase<1, false>(C, P, nullptr, PRE, P.in[41], P.in[42], P.out, nullptr, nullptr); } SEAM(PH(31));
    CHECK(31, chk_ln_moe(C, P, 31, PRE, P.in[41], P.in[42], P.out, nullptr));
#if MK_CHECK
    if (IN(2 * NPHASE)) {
        const float* ck = (const float*)ctl + CW_CHK; int bad = -1;
        for (int p = 0; p < NPHASE; ++p) { const float e2 = __hip_atomic_load(ck + 2 * p, __ATOMIC_RELAXED, __HIP_MEMORY_SCOPE_AGENT), r2 = __hip_atomic_load(ck + 2 * p + 1, __ATOMIC_RELAXED, __HIP_MEMORY_SCOPE_AGENT); if (bad < 0 && !(e2 <= 2e-4f * r2)) bad = p; }
        float code = bad >= 0 ? (float)(10 + 2 * bad) : 0.f;
        if (__hip_atomic_load(ctl + CW_BAR + XB_TMO, __ATOMIC_RELAXED, __HIP_MEMORY_SCOPE_AGENT) != 0u || __hip_atomic_load(ctl + 1, __ATOMIC_RELAXED, __HIP_MEMORY_SCOPE_AGENT) != 0u) code = 98.f;
        if (code > 0.f) { const float v = sqrtf(code - 1.f); for (int i = C.bid * 512 + C.tid; i < M * D; i += C.G * 512) P.out[i] = v; }
    }
#endif
#undef IN
#undef SEAM
#undef CHECK
#undef PH
}

extern "C" void kernel_launch(void* const* d_in, const int* in_sizes, int n_in, void* d_out, int out_size, void* d_ws, size_t ws_size, hipStream_t stream) {
    static int grid = 0;
    if (grid == 0) {
        if (n_in != 43 || in_sizes[0] != M * D || out_size != M * D || ws_size < WS_END) { fprintf(stderr, "kernel_launch: unexpected shapes (n_in %d, in0 %d, out %d, ws %zu)\n", n_in, n_in > 0 ? in_sizes[0] : -1, out_size, ws_size); grid = -1; return; }
        int dev = 0, cus = 0, per_cu = 0;
        if (hipGetDevice(&dev) != hipSuccess || hipDeviceGetAttribute(&cus, hipDeviceAttributeMultiprocessorCount, dev) != hipSuccess) { grid = -1; return; }
        if (hipFuncSetAttribute((const void*)hybrid_fwd, hipFuncAttributeMaxDynamicSharedMemorySize, LDS_BYTES) != hipSuccess) { fprintf(stderr, "kernel_launch: hipFuncSetAttribute failed\n"); grid = -1; return; }
        if (hipOccupancyMaxActiveBlocksPerMultiprocessor(&per_cu, (const void*)hybrid_fwd, NWAVES * 64, LDS_BYTES) != hipSuccess || per_cu < 1) { fprintf(stderr, "kernel_launch: occupancy query says %d\n", per_cu); }
        (void)hipGetLastError();
        grid = cus;
        if (grid != 256) { fprintf(stderr, "kernel_launch: built for 256 CUs, device has %d\n", cus); grid = -1; return; }
    }
    if (grid < 0) return;
    (void)hipMemsetAsync((char*)d_ws + WS_CTL, 0, CTL_ZERO_BYTES, stream);
    Params p{};
    for (int i = 0; i < 43; ++i) p.in[i] = (const float*)d_in[i];
    p.positions = (const int*)d_in[1]; p.out = (float*)d_out; p.ws = (unsigned char*)d_ws;
#if MK_PER_PHASE
    for (int s = 0; s < NSTEPS; ++s) { p.step_lo = s; p.step_hi = s + 1; hipLaunchKernelGGL(hybrid_fwd, dim3(grid), dim3(NWAVES * 64), LDS_BYTES, stream, p); }
#else
    p.step_lo = 0; p.step_hi = NSTEPS;
    hipLaunchKernelGGL(hybrid_fwd, dim3(grid), dim3(NWAVES * 64), LDS_BYTES, stream, p);
#endif
}
```

```cpp
#include <hip/hip_runtime.h>
#include <cstdio>
#include <cstdint>

#ifndef MK_CHECK
#define MK_CHECK 0
#endif
#ifndef MK_PER_PHASE
#define MK_PER_PHASE 0
#endif

#ifndef MK_REP_MASK
#define MK_REP_MASK 0ull
#endif

#ifndef MK_DRY
#define MK_DRY 0
#endif

#define LAS __attribute__((address_space(3)))
#define GAS __attribute__((address_space(1)))
typedef unsigned short bf16_t;
typedef short bf16x8 __attribute__((ext_vector_type(8)));
typedef short s16x4 __attribute__((ext_vector_type(4)));
typedef float f32x4 __attribute__((ext_vector_type(4)));
typedef float f32x2 __attribute__((ext_vector_type(2)));
typedef float f32x16 __attribute__((ext_vector_type(16)));
typedef unsigned u32x4 __attribute__((ext_vector_type(4)));
typedef unsigned u32x2 __attribute__((ext_vector_type(2)));

constexpr int M = 16384, D = 1024, SEQ = 2048, NBATCH = 8;
constexpr int FF = 2816, FFE = 3584, NE = 8;
constexpr int QKVW = 9216;
constexpr float ALPHA = 1.6817928305074292f;
constexpr float LN_EPS = 1e-5f;
constexpr float QSCALE = 0.125f * 1.4426950408889634f;
constexpr int MOE_ROWS_MAX = 32768 + 8 * 256;

__device__ __forceinline__ unsigned cvt_pk_bf16(float lo, float hi) { unsigned r; asm volatile("v_cvt_pk_bf16_f32 %0, %1, %2" : "=v"(r) : "v"(lo), "v"(hi)); return r; }
__device__ __forceinline__ unsigned f2bf(float f) { unsigned u = __builtin_bit_cast(unsigned, f); return (u + 0x7fffu + ((u >> 16) & 1u)) >> 16; }
__device__ __forceinline__ unsigned pk2(float lo, float hi) { return f2bf(lo) | (f2bf(hi) << 16); }
__device__ __forceinline__ float bf2f(unsigned b) { return __builtin_bit_cast(float, b << 16); }
__device__ __forceinline__ float bflo(unsigned w) { return __builtin_bit_cast(float, w << 16); }
__device__ __forceinline__ float bfhi(unsigned w) { return __builtin_bit_cast(float, w & 0xffff0000u); }
__device__ __forceinline__ float silu_f(float x) { return x * __builtin_amdgcn_rcpf(1.0f + __builtin_amdgcn_exp2f(-1.4426950408889634f * x)); }

namespace pg8 {
constexpr int BM = 256, BK = 64, HALF = 128, HTB = HALF * BK * 2  , STAGE_BYTES = 8 * HTB, NXCD = 8, WGM = 8;
__host__ __device__ __forceinline__ int lds_byte(int r, int c) { const int st = (r >> 4) * 2 + (c >> 5), rr = r & 15, cc = c & 31, ob = rr * 64 + cc * 2; return st * 1024 + (ob ^ (((ob >> 9) & 1) << 5)); }
__host__ __device__ __forceinline__ void stage_rc(int b, int& R, int& C) { const int st = b / 1024, sb = b % 1024, swz = sb ^ (((sb >> 9) & 1) << 5); R = (st >> 1) * 16 + swz / 64; C = (st & 1) * 32 + (swz % 64) / 2; }
__host__ __device__ __forceinline__ int perm32(int rho) { const int n = rho >> 4, i = rho & 15; return 8 * (i >> 2) + 4 * n + (i & 3); }

struct Unit { int pm, pn; unsigned ao, bo; int kc; };
struct Gemm { const bf16_t* A; const bf16_t* Bt; int lda, ldb, K; };

struct StaticOrder {
    int nM, nN, nwg, G, c; unsigned ao_pn;
    __device__ void init(int nM_, int nN_, int G_, int c_, unsigned ao_pn_ = 0u) { nM = nM_; nN = nN_; nwg = nM * nN; G = G_; c = c_; ao_pn = ao_pn_; }
    __device__ __forceinline__ bool next(int i, Unit& u) const {
        const long L = (long)i * G + c; if (L >= nwg) return false;
        int wgid = (int)L; { const int q = nwg / NXCD, r = nwg % NXCD, xcd = wgid % NXCD, off = wgid / NXCD; wgid = (xcd < r ? xcd * (q + 1) : r * (q + 1) + (xcd - r) * q) + off; }
        const int nig = WGM * nN, gid = wgid / nig, fm = gid * WGM, gsz = (nM - fm) < WGM ? (nM - fm) : WGM;
        u.pm = fm + ((wgid % nig) % gsz); u.pn = (wgid % nig) / gsz; u.ao = ao_pn * (unsigned)u.pn; u.bo = 0u; u.kc = 0; return true;
    }
};
struct MoeOrder {
    StaticOrder so; int o1, o2, o3, o4, o5, o6, o7; unsigned estride;
    __device__ __forceinline__ bool next(int i, Unit& u) const {
        if (!so.next(i, u)) return false;
        const int row = u.pm * 256;
        const int e = (row >= o1) + (row >= o2) + (row >= o3) + (row >= o4) + (row >= o5) + (row >= o6) + (row >= o7);
        u.bo = (unsigned)e * estride; return true;
    }
};

struct MoeTailOrder {
    int nextra, G, c; int o1, o2, o3, o4, o5, o6, o7; unsigned estride;
    __device__ __forceinline__ bool next(int i, Unit& u) const {
        const int L = i * G + c; if (L >= nextra * 28) return false;
        const int et = L / 28, rem = L - et * 28; u.pn = rem / 7; u.kc = rem - u.pn * 7; u.pm = 128 + et;
        const int row = u.pm * 256;
        const int e = (row >= o1) + (row >= o2) + (row >= o3) + (row >= o4) + (row >= o5) + (row >= o6) + (row >= o7);
        u.ao = (unsigned)u.kc * 1024u; u.bo = (unsigned)e * estride + (unsigned)u.kc * 1024u; return true;
    }
};

struct EpiBf16 {
    static constexpr bool PERM = true;
    bf16_t* O; int ldc;
    __device__ __forceinline__ void operator()(const f32x4 (&acc)[2][2][4][2], const Unit& u, int wr, int wc, int fr, int fq) const {
        const int row0 = u.pm * BM + wr * 64 + fr, col0 = u.pn * BM + wc * 32 + 8 * fq;
#pragma unroll
        for (int ai = 0; ai < 2; ++ai)
#pragma unroll
            for (int m = 0; m < 4; ++m) { bf16_t* rowp = O + (size_t)(row0 + ai * HALF + m * 16) * ldc + col0;
#pragma unroll
                for (int bj = 0; bj < 2; ++bj) { const f32x4 v0 = acc[ai][bj][m][0], v1 = acc[ai][bj][m][1];
                    u32x4 w; w.x = cvt_pk_bf16(v0[0], v0[1]); w.y = cvt_pk_bf16(v0[2], v0[3]); w.z = cvt_pk_bf16(v1[0], v1[1]); w.w = cvt_pk_bf16(v1[2], v1[3]);
                    *(u32x4*)(rowp + bj * HALF) = w; } }
    }
};
struct EpiSwiGLU {
    static constexpr bool PERM = true;
    bf16_t* O; int ldc; int rowlim;
    __device__ __forceinline__ void operator()(const f32x4 (&acc)[2][2][4][2], const Unit& u, int wr, int wc, int fr, int fq) const {
        const int row0 = u.pm * BM + wr * 64 + fr, col0 = u.pn * HALF + wc * 32 + 8 * fq;
#pragma unroll
        for (int ai = 0; ai < 2; ++ai)
#pragma unroll
            for (int m = 0; m < 4; ++m) { bf16_t* rowp = O + (size_t)(row0 + ai * HALF + m * 16) * ldc + col0;
                const f32x4 g0 = acc[ai][0][m][0], g1 = acc[ai][0][m][1], u0 = acc[ai][1][m][0], u1 = acc[ai][1][m][1];
                float h[8];
#pragma unroll
                for (int j = 0; j < 4; ++j) { h[j] = silu_f(g0[j]) * u0[j]; h[4 + j] = silu_f(g1[j]) * u1[j]; }
                u32x4 w; w.x = cvt_pk_bf16(h[0], h[1]); w.y = cvt_pk_bf16(h[2], h[3]); w.z = cvt_pk_bf16(h[4], h[5]); w.w = cvt_pk_bf16(h[6], h[7]);
                if (!MK_DRY || row0 < rowlim) *(u32x4*)rowp = w; }
    }
};
struct EpiConvIn {
    static constexpr bool PERM = true;
    bf16_t* Bo; bf16_t* Zo;
    __device__ __forceinline__ void operator()(const f32x4 (&acc)[2][2][4][2], const Unit& u, int wr, int wc, int fr, int fq) const {
        const int row0 = u.pm * BM + wr * 64 + fr;
        if (u.pn < 4) {
            const int col0 = u.pn * BM + wc * 32 + 8 * fq;
#pragma unroll
            for (int ai = 0; ai < 2; ++ai)
#pragma unroll
                for (int m = 0; m < 4; ++m) { bf16_t* rowp = Bo + (size_t)(row0 + ai * HALF + m * 16) * D + col0;
#pragma unroll
                    for (int bj = 0; bj < 2; ++bj) { const f32x4 v0 = acc[ai][bj][m][0], v1 = acc[ai][bj][m][1];
                        u32x4 w; w.x = cvt_pk_bf16(v0[0], v0[1]); w.y = cvt_pk_bf16(v0[2], v0[3]); w.z = cvt_pk_bf16(v1[0], v1[1]); w.w = cvt_pk_bf16(v1[2], v1[3]);
                        *(u32x4*)(rowp + bj * HALF) = w; } }
        } else {
            const int col0 = (u.pn - 4) * HALF + wc * 32 + 8 * fq;
#pragma unroll
            for (int ai = 0; ai < 2; ++ai)
#pragma unroll
                for (int m = 0; m < 4; ++m) { bf16_t* rowp = Zo + (size_t)(row0 + ai * HALF + m * 16) * D + col0;
                    const f32x4 c0 = acc[ai][0][m][0], c1 = acc[ai][0][m][1], u0 = acc[ai][1][m][0], u1 = acc[ai][1][m][1];
                    u32x4 w; w.x = cvt_pk_bf16(c0[0] * u0[0], c0[1] * u0[1]); w.y = cvt_pk_bf16(c0[2] * u0[2], c0[3] * u0[3]); w.z = cvt_pk_bf16(c1[0] * u1[0], c1[1] * u1[1]); w.w = cvt_pk_bf16(c1[2] * u1[2], c1[3] * u1[3]);
                    *(u32x4*)rowp = w; }
        }
    }
};
struct EpiQKV {
    static constexpr bool PERM = true;
    bf16_t* O; const float* cosT; const float* sinT;
    __device__ __forceinline__ void operator()(const f32x4 (&acc)[2][2][4][2], const Unit& u, int wr, int wc, int fr, int fq) const {
        const int row0 = u.pm * BM + wr * 64 + fr, col0 = u.pn * BM + wc * 32 + 8 * fq;
        const int kind = (u.pn % 12) >> 2;
        const bool rot = (kind < 2) && ((wc & 1) == 0);
        const float qs = (kind == 0) ? QSCALE : 1.0f;
#pragma unroll
        for (int ai = 0; ai < 2; ++ai) {
            f32x4 cs[4][2], sn[4][2];
#pragma unroll
            for (int m = 0; m < 4; ++m) { const int row = row0 + ai * HALF + m * 16;
                if (rot) { cs[m][0] = *(const f32x4*)(cosT + (size_t)row * 8); cs[m][1] = *(const f32x4*)(cosT + (size_t)row * 8 + 4); sn[m][0] = *(const f32x4*)(sinT + (size_t)row * 8); sn[m][1] = *(const f32x4*)(sinT + (size_t)row * 8 + 4); }
                else { cs[m][0] = cs[m][1] = (f32x4){1.f, 1.f, 1.f, 1.f}; sn[m][0] = sn[m][1] = (f32x4){0.f, 0.f, 0.f, 0.f}; } }
#pragma unroll
            for (int m = 0; m < 4; ++m) { const int row = row0 + ai * HALF + m * 16; bf16_t* rowp = O + (size_t)row * QKVW + col0;
#pragma unroll
                for (int bj = 0; bj < 2; ++bj) { f32x4 v0 = acc[ai][bj][m][0], v1 = acc[ai][bj][m][1];
                    if (rot) {
                        f32x4 p0, p1;
#pragma unroll
                        for (int j = 0; j < 4; ++j) { p0[j] = __shfl_xor(v0[j], 16); p1[j] = __shfl_xor(v1[j], 16); }
                        if (fq == 0) { v0 = v0 * cs[m][0] - p0 * sn[m][0]; v1 = v1 * cs[m][1] - p1 * sn[m][1]; }
                        else if (fq == 1) { v0 = p0 * sn[m][0] + v0 * cs[m][0]; v1 = p1 * sn[m][1] + v1 * cs[m][1]; }
                    }
                    v0 = v0 * qs; v1 = v1 * qs;
                    u32x4 w; w.x = cvt_pk_bf16(v0[0], v0[1]); w.y = cvt_pk_bf16(v0[2], v0[3]); w.z = cvt_pk_bf16(v1[0], v1[1]); w.w = cvt_pk_bf16(v1[2], v1[3]);
                    *(u32x4*)(rowp + bj * HALF) = w; } }
        }
    }
};
struct EpiPre {
    static constexpr bool PERM = false;
    const float* X; float* P; const float* scale;
    __device__ __forceinline__ void operator()(const f32x4 (&acc)[2][2][4][2], const Unit& u, int wr, int wc, int fr, int fq) const {
        const int row0 = u.pm * BM + wr * 64 + fr, col0 = u.pn * BM + wc * 32 + 4 * fq;
        f32x4 sc[2][2];
#pragma unroll
        for (int bj = 0; bj < 2; ++bj)
#pragma unroll
            for (int n = 0; n < 2; ++n) sc[bj][n] = scale ? *(const f32x4*)(scale + col0 + bj * HALF + n * 16) : (f32x4){1.f, 1.f, 1.f, 1.f};
        f32x4 xv[2][4];
#pragma unroll
        for (int q = 0; q < 4; ++q) xv[0][q] = *(const f32x4*)(X + (size_t)row0 * D + col0 + (q >> 1) * HALF + (q & 1) * 16);
#pragma unroll
        for (int rg = 0; rg < 8; ++rg) { const int ai = rg >> 2, m = rg & 3; const size_t off = (size_t)(row0 + ai * HALF + m * 16) * D + col0;
            if (rg < 7) { const int ai2 = (rg + 1) >> 2, m2 = (rg + 1) & 3; const size_t off2 = (size_t)(row0 + ai2 * HALF + m2 * 16) * D + col0;
#pragma unroll
                for (int q = 0; q < 4; ++q) xv[(rg + 1) & 1][q] = *(const f32x4*)(X + off2 + (q >> 1) * HALF + (q & 1) * 16); }
#pragma unroll
            for (int q = 0; q < 4; ++q) { const int bj = q >> 1, n = q & 1; *(f32x4*)(P + off + bj * HALF + n * 16) = xv[rg & 1][q] * ALPHA + acc[ai][bj][m][n] * sc[bj][n]; } }
    }
};
struct EpiMoeDown {
    static constexpr bool PERM = true;
    bf16_t* O; const float* rowgate;
    __device__ __forceinline__ void operator()(const f32x4 (&acc)[2][2][4][2], const Unit& u, int wr, int wc, int fr, int fq) const {
        const int row0 = u.pm * BM + wr * 64 + fr, col0 = u.pn * BM + wc * 32 + 8 * fq;
        float gt[8];
#pragma unroll
        for (int rg = 0; rg < 8; ++rg) gt[rg] = rowgate[row0 + (rg >> 2) * HALF + (rg & 3) * 16];
#pragma unroll
        for (int ai = 0; ai < 2; ++ai)
#pragma unroll
            for (int m = 0; m < 4; ++m) { const int row = row0 + ai * HALF + m * 16; const float g1 = gt[ai * 4 + m]; bf16_t* rowp = O + (size_t)row * D + col0;
#pragma unroll
                for (int bj = 0; bj < 2; ++bj) { const f32x4 v0 = acc[ai][bj][m][0] * g1, v1 = acc[ai][bj][m][1] * g1;
                    u32x4 w; w.x = cvt_pk_bf16(v0[0], v0[1]); w.y = cvt_pk_bf16(v0[2], v0[3]); w.z = cvt_pk_bf16(v1[0], v1[1]); w.w = cvt_pk_bf16(v1[2], v1[3]);
                    *(u32x4*)(rowp + bj * HALF) = w; } }
    }
};
struct EpiMoeDownPart {
    static constexpr bool PERM = true;
    bf16_t* YP; const float* rowgate;
    __device__ __forceinline__ void operator()(const f32x4 (&acc)[2][2][4][2], const Unit& u, int wr, int wc, int fr, int fq) const {
        const int row0 = u.pm * BM + wr * 64 + fr, col0 = u.pn * BM + wc * 32 + 8 * fq;
        float gt[8];
#pragma unroll
        for (int rg = 0; rg < 8; ++rg) gt[rg] = rowgate[row0 + (rg >> 2) * HALF + (rg & 3) * 16];
        bf16_t* base = YP + (size_t)u.kc * 2048 * D;
#pragma unroll
        for (int ai = 0; ai < 2; ++ai)
#pragma unroll
            for (int m = 0; m < 4; ++m) { const int row = row0 + ai * HALF + m * 16 - 32768; const float g1 = gt[ai * 4 + m]; bf16_t* rowp = base + (size_t)row * D + col0;
#pragma unroll
                for (int bj = 0; bj < 2; ++bj) { const f32x4 v0 = acc[ai][bj][m][0] * g1, v1 = acc[ai][bj][m][1] * g1;
                    u32x4 w; w.x = cvt_pk_bf16(v0[0], v0[1]); w.y = cvt_pk_bf16(v0[2], v0[3]); w.z = cvt_pk_bf16(v1[0], v1[1]); w.w = cvt_pk_bf16(v1[2], v1[3]);
                    *(u32x4*)(rowp + bj * HALF) = w; } }
    }
};

template <class Epi, class Sched, bool ALIGN_EPI = true, bool SP2 = true>
__device__ __forceinline__ void gemm_phase(LAS unsigned char* lds, const Gemm g, const Sched& S, const Epi& E) {
    const int tid = threadIdx.x, wid = __builtin_amdgcn_readfirstlane(tid >> 6), lane = tid & 63, wr = wid >> 2, wc = wid & 3, fr = lane & 15, fq = lane >> 4;
    const int K = g.K, nt = K / BK;
    unsigned voffA[2], voffB[2];
#pragma unroll
    for (int i = 0; i < 2; ++i) { int R, C; stage_rc(tid * 16 + i * 8192, R, C); const int Rb = Epi::PERM ? ((R & ~31) + perm32(R & 31)) : R;
        voffA[i] = (unsigned)(R * g.lda + C) * 2u; voffB[i] = (unsigned)(Rb * g.ldb + C) * 2u; }
    const size_t kstep = (size_t)(BK * 2);
    const size_t hstepA = (size_t)HALF * g.lda * 2, hstepB = (size_t)HALF * g.ldb * 2;
    const size_t tstepA = 2 * hstepA, tstepB = 2 * hstepB;
    const unsigned ldsw = (unsigned)wid * 1024u;
    const int aoff = lds_byte(wr * 64 + fr, fq * 8), boff = lds_byte(wc * 32 + fr, fq * 8);
#define PG8_SA(b, h) (((b) * 2 + (h)) * HTB)
#define PG8_SB(b, h) ((4 + (b) * 2 + (h)) * HTB)
#define PG8_STAGE(bufoff, gbase, voff) do { _Pragma("unroll") for (int _i = 0; _i < 2; ++_i) \
        __builtin_amdgcn_global_load_lds((const unsigned*)((const char*)(gbase) + (voff)[_i]), (LAS unsigned*)(lds + (bufoff) + ldsw + _i * 8192), 16, 0, 0); } while (0)
#define PG8_LDA(dst, b, h) do { _Pragma("unroll") for (int m = 0; m < 4; ++m) _Pragma("unroll") for (int k = 0; k < 2; ++k) dst[m][k] = *(const LAS bf16x8*)(lds + PG8_SA(b, h) + aoff + m * 2048 + k * 1024); } while (0)
#define PG8_LDB(dst, b, h) do { _Pragma("unroll") for (int n = 0; n < 2; ++n) _Pragma("unroll") for (int k = 0; k < 2; ++k) dst[n][k] = *(const LAS bf16x8*)(lds + PG8_SB(b, h) + boff + n * 2048 + k * 1024); } while (0)
#define PG8_MMA(ai, bj, At, Bt) do { __builtin_amdgcn_s_setprio(1); _Pragma("unroll") for (int m = 0; m < 4; ++m) _Pragma("unroll") for (int n = 0; n < 2; ++n) _Pragma("unroll") for (int k = 0; k < 2; ++k) \
        acc[ai][bj][m][n] = __builtin_amdgcn_mfma_f32_16x16x32_bf16(Bt[n][k], At[m][k], acc[ai][bj][m][n], 0, 0, 0); __builtin_amdgcn_s_setprio(0); } while (0)
#define PG8_WAIT_V(n) asm volatile("s_waitcnt vmcnt(" #n ")" ::: "memory")
#define PG8_WAIT_L(n) asm volatile("s_waitcnt lgkmcnt(" #n ")" ::: "memory")
#define PG8_BAR __builtin_amdgcn_s_barrier()
#define PG8_SCHED __builtin_amdgcn_sched_barrier(0)
    Unit cur, nxt; int ui = 0;
    if (!S.next(0, cur)) return;
    f32x4 acc[2][2][4][2];
#pragma unroll
    for (int a = 0; a < 2; ++a)
#pragma unroll
        for (int b = 0; b < 2; ++b)
#pragma unroll
            for (int m = 0; m < 4; ++m)
#pragma unroll
                for (int n = 0; n < 2; ++n) acc[a][b][m][n] = (f32x4){0.f, 0.f, 0.f, 0.f};
    bf16x8 At[4][2], B0[2][2], B1[2][2];
    const char* cA = (const char*)g.A + (size_t)cur.pm * tstepA + cur.ao; const char* cB = (const char*)g.Bt + (size_t)cur.pn * tstepB + cur.bo;
    if constexpr (SP2) {
        PG8_STAGE(PG8_SB(0, 0), cB, voffB); PG8_STAGE(PG8_SB(0, 1), cB + hstepB, voffB); PG8_STAGE(PG8_SA(0, 0), cA, voffA); PG8_STAGE(PG8_SA(0, 1), cA + hstepA, voffA);
        if (wr == 1) PG8_BAR;
        PG8_WAIT_V(2); PG8_BAR;
        PG8_STAGE(PG8_SB(1, 0), cB + kstep, voffB); PG8_STAGE(PG8_SA(1, 0), cA + kstep, voffA); PG8_STAGE(PG8_SB(1, 1), cB + hstepB + kstep, voffB);
        PG8_WAIT_V(6); PG8_BAR;
    } else {
        PG8_STAGE(PG8_SB(0, 0), cB, voffB); PG8_STAGE(PG8_SA(0, 0), cA, voffA); PG8_STAGE(PG8_SB(0, 1), cB + hstepB, voffB); PG8_STAGE(PG8_SA(0, 1), cA + hstepA, voffA);
        if (wr == 1) PG8_BAR;
        PG8_WAIT_V(4); PG8_BAR;
        PG8_STAGE(PG8_SB(1, 0), cB + kstep, voffB); PG8_STAGE(PG8_SA(1, 0), cA + kstep, voffA); PG8_STAGE(PG8_SB(1, 1), cB + hstepB + kstep, voffB);
        PG8_WAIT_V(6); PG8_BAR;
    }
    for (;;) {
        const bool has_next = S.next(ui + 1, nxt);
        const char* nA = has_next ? (const char*)g.A + (size_t)nxt.pm * tstepA + nxt.ao : cA; const char* nB = has_next ? (const char*)g.Bt + (size_t)nxt.pn * tstepB + nxt.bo : cB;
        for (int t = 0; t < nt; t += 2) {
            const bool last = (t == nt - 2);
            const char* a1 = cA + (size_t)(t + 1) * kstep;
            const char* a2 = last ? nA : cA + (size_t)(t + 2) * kstep; const char* b2 = last ? nB : cB + (size_t)(t + 2) * kstep;
            const char* a3 = a2 + kstep; const char* b3 = b2 + kstep;
            if constexpr (SP2) {
            PG8_LDB(B0, 0, 0); PG8_LDB(B1, 0, 1); PG8_SCHED; PG8_LDA(At, 0, 0); PG8_STAGE(PG8_SA(1, 1), a1 + hstepA, voffA);
            PG8_WAIT_V(8); PG8_WAIT_L(0); PG8_BAR; PG8_MMA(0, 0, At, B0); PG8_MMA(0, 1, At, B1); PG8_BAR; PG8_SCHED;
            PG8_LDA(At, 0, 1); PG8_STAGE(PG8_SB(0, 0), b2, voffB); PG8_STAGE(PG8_SB(0, 1), b2 + hstepB, voffB); PG8_STAGE(PG8_SA(0, 0), a2, voffA);
            PG8_WAIT_V(8); PG8_WAIT_L(0); PG8_BAR; PG8_MMA(1, 0, At, B0); PG8_MMA(1, 1, At, B1); PG8_BAR; PG8_SCHED;
            PG8_LDB(B0, 1, 0); PG8_LDB(B1, 1, 1); PG8_SCHED; PG8_LDA(At, 1, 0); PG8_STAGE(PG8_SA(0, 1), a2 + hstepA, voffA);
            PG8_WAIT_V(8); PG8_WAIT_L(0); PG8_BAR; PG8_MMA(0, 0, At, B0); PG8_MMA(0, 1, At, B1); PG8_BAR; PG8_SCHED;
            PG8_LDA(At, 1, 1); PG8_STAGE(PG8_SB(1, 0), b3, voffB); PG8_STAGE(PG8_SB(1, 1), b3 + hstepB, voffB); PG8_STAGE(PG8_SA(1, 0), a3, voffA);
            PG8_WAIT_V(8); PG8_WAIT_L(0); PG8_BAR; PG8_MMA(1, 0, At, B0); PG8_MMA(1, 1, At, B1); PG8_BAR; PG8_SCHED;
            } else {
            PG8_LDB(B0, 0, 0); PG8_SCHED; PG8_LDA(At, 0, 0); PG8_STAGE(PG8_SA(1, 1), a1 + hstepA, voffA);
            PG8_WAIT_L(8); PG8_BAR; PG8_WAIT_L(0); PG8_MMA(0, 0, At, B0); PG8_BAR; PG8_SCHED;
            PG8_LDB(B1, 0, 1); PG8_STAGE(PG8_SB(0, 0), b2, voffB);
            PG8_BAR; PG8_WAIT_L(0); PG8_MMA(0, 1, At, B1); PG8_BAR;
            PG8_LDA(At, 0, 1); PG8_STAGE(PG8_SA(0, 0), a2, voffA);
            PG8_BAR; PG8_WAIT_L(0); PG8_MMA(1, 0, At, B0); PG8_BAR; PG8_SCHED;
            PG8_STAGE(PG8_SB(0, 1), b2 + hstepB, voffB);
            PG8_WAIT_V(6); PG8_BAR; PG8_MMA(1, 1, At, B1); PG8_BAR;
            PG8_LDB(B0, 1, 0); PG8_SCHED; PG8_LDA(At, 1, 0); PG8_STAGE(PG8_SA(0, 1), a2 + hstepA, voffA);
            PG8_WAIT_L(8); PG8_BAR; PG8_WAIT_L(0); PG8_MMA(0, 0, At, B0); PG8_BAR; PG8_SCHED;
            PG8_LDB(B1, 1, 1); PG8_STAGE(PG8_SB(1, 0), b3, voffB);
            PG8_BAR; PG8_WAIT_L(0); PG8_MMA(0, 1, At, B1); PG8_BAR;
            PG8_LDA(At, 1, 1); PG8_STAGE(PG8_SA(1, 0), a3, voffA);
            PG8_BAR; PG8_WAIT_L(0); PG8_MMA(1, 0, At, B0); PG8_BAR; PG8_SCHED;
            PG8_STAGE(PG8_SB(1, 1), b3 + hstepB, voffB);
            PG8_WAIT_V(6); PG8_BAR; PG8_MMA(1, 1, At, B1); PG8_BAR;
            }
        }
        if constexpr (ALIGN_EPI) { if (wr == 0) PG8_BAR; }
        E(acc, cur, wr, wc, fr, fq);
        if (!has_next) break;
#pragma unroll
        for (int a = 0; a < 2; ++a)
#pragma unroll
            for (int b = 0; b < 2; ++b)
#pragma unroll
                for (int m = 0; m < 4; ++m)
#pragma unroll
                    for (int n = 0; n < 2; ++n) acc[a][b][m][n] = (f32x4){0.f, 0.f, 0.f, 0.f};
        cur = nxt; cA = nA; cB = nB; ++ui;
        if constexpr (ALIGN_EPI) { if (wr == 1) PG8_BAR; }
    }
    PG8_WAIT_V(0);
    if constexpr (!ALIGN_EPI) { if (wr == 0) PG8_BAR; }
    PG8_BAR;
#undef PG8_SA
#undef PG8_SB
#undef PG8_STAGE
#undef PG8_LDA
#undef PG8_LDB
#undef PG8_MMA
#undef PG8_WAIT_V
#undef PG8_WAIT_L
#undef PG8_BAR
#undef PG8_SCHED
}
}

constexpr size_t MiB = 1u << 20;
constexpr size_t WS_CTL = 0, CTL_ZERO_BYTES = 1 * MiB;
constexpr size_t WS_ROPE = 1 * MiB;
constexpr size_t WS_MISC = 2 * MiB;
constexpr size_t WS_XF = 4 * MiB;
constexpr size_t WS_XB = 68 * MiB;
constexpr size_t WS_PRE = 100 * MiB;
constexpr size_t WS_WB = 164 * MiB;
constexpr size_t WS_BIG = 354 * MiB;
constexpr size_t WS_AUX = 642 * MiB;
constexpr size_t WS_END = 778 * MiB;
constexpr size_t MS_SEL = 0, MS_GATE = 128 * 1024, MS_POS = 256 * 1024, MS_WGCNT = 384 * 1024, MS_OFF = 392 * 1024, MS_ROWGATE = 400 * 1024;
constexpr size_t WB_MIX0 = 0;
constexpr size_t WB_MIX1 = (size_t)QKVW * D;
constexpr size_t WB_FFN0 = 11u * 1048576u;
constexpr size_t WB_FFN1_DENSE = WB_FFN0 + (size_t)2 * FF * D;
constexpr size_t WB_FFN1_MOE = WB_FFN0 + (size_t)NE * 2 * FFE * D;
static_assert((WB_FFN1_MOE + (size_t)NE * D * FFE) * 2 <= 190 * MiB, "weights region");
static_assert(WB_MIX1 + (size_t)D * D <= WB_FFN0, "mixer weights region");
constexpr size_t BG_QKV = 0;
constexpr size_t BG_HID = 0;
constexpr size_t BG_U = 256 * MiB;
constexpr size_t BG_P = 224 * MiB;
constexpr size_t BG_YP = 256 * MiB;
constexpr size_t BG_G = 192 * MiB;
static_assert((size_t)MOE_ROWS_MAX * FFE * 2 <= 288 * MiB && (size_t)M * QKVW * 2 <= 288 * MiB, "big region");
constexpr size_t AX_OG = 0;
constexpr size_t AX_LSE = 96 * MiB;
constexpr size_t AX_ATT = 100 * MiB;
constexpr size_t AX_XPERM = 0;
constexpr size_t AX_Y = 68 * MiB;
static_assert(AX_Y + (size_t)MOE_ROWS_MAX * D * 2 <= 136 * MiB && AX_ATT + 32 * MiB <= 136 * MiB, "aux region");

constexpr int CW_BAR = 4096;
constexpr int CW_CHK = 16384;
constexpr int RING_BYTES = 131072;
constexpr int LDSCTL_OFF = RING_BYTES, MISC_OFF = LDSCTL_OFF + 320;
constexpr int LDS_BYTES = 147456;
constexpr int NWAVES = 8;

#define LDS_WAIT() asm volatile("s_waitcnt lgkmcnt(0)" ::: "memory")
#define VM_WAIT() asm volatile("s_waitcnt vmcnt(0)" ::: "memory")

#define XB_TMO      128
#define XB_XCNT(j)  (256  + 64 * (j))
#define XB_XSUB(j)  (1280 + 64 * (j))
#define XB_XGEN(j)  (2304 + 64 * (j))
#define XB_TOP      3328
#define XB_TOPGEN   3392
#define XCD_BAR_WORDS 3456
#define XB_SPIN_CAP (1u << 18)

__device__ __forceinline__ unsigned xb_ld(unsigned* p)              { return __hip_atomic_load(p, __ATOMIC_RELAXED, __HIP_MEMORY_SCOPE_AGENT); }
__device__ __forceinline__ unsigned xb_add(unsigned* p, unsigned v) { return __hip_atomic_fetch_add(p, v, __ATOMIC_RELAXED, __HIP_MEMORY_SCOPE_AGENT); }
__device__ __forceinline__ unsigned xb_xcc_id() { return (unsigned)__builtin_amdgcn_s_getreg((3 << 11) | 20) & 0xFu; }
#define XB_SPIN(cond, bar) do { unsigned _sp = 0; while (cond) { __builtin_amdgcn_s_sleep(1); \
    if ((++_sp & 255u) == 0u) { if (xb_ld(&(bar)[XB_TMO])) break; if (_sp > XB_SPIN_CAP) { atomicAdd(&(bar)[XB_TMO], 1u); break; } } } } while (0)

struct XcdBarrier {
    unsigned* bar; unsigned x;
    volatile LAS unsigned* st;
};
__device__ __forceinline__ XcdBarrier xcd_barrier_post(unsigned* bar, volatile LAS unsigned* st) {
    XcdBarrier b; b.bar = bar; b.x = xb_xcc_id(); b.st = st;
    if (threadIdx.x == 0) (void)xb_add(&bar[XB_XCNT(b.x)], 1u);
    return b;
}
__device__ __forceinline__ void xcd_barrier_complete(unsigned* bar, unsigned x, unsigned& nloc, unsigned& nx) {
    const unsigned G = gridDim.x * gridDim.y * gridDim.z;
    unsigned sum, cnt, mine, sp = 0u;
    for (;;) {
        sum = 0u; cnt = 0u; mine = 0u;
#pragma unroll
        for (unsigned j = 0; j < 16; ++j) { const unsigned c = xb_ld(&bar[XB_XCNT(j)]); sum += c; cnt += (c > 0u) ? 1u : 0u; mine = (j == x) ? c : mine; }
        if (sum == G) break;
        __builtin_amdgcn_s_sleep(1);
        if ((++sp & 255u) == 0u) { if (xb_ld(&bar[XB_TMO])) break; if (sp > XB_SPIN_CAP) { atomicAdd(&bar[XB_TMO], 1u); break; } }
    }
    nloc = mine > 0u ? mine : 1u; nx = cnt > 0u ? cnt : 1u;
}
__device__ __forceinline__ void xcd_barrier(const XcdBarrier& b) {
    asm volatile("s_waitcnt vmcnt(0)" ::: "memory");
    __syncthreads();
    if (threadIdx.x == 0) {
        unsigned* bar = b.bar;
        __builtin_amdgcn_s_waitcnt(0);
        unsigned nloc = b.st[0], nx = b.st[1];
        if (nloc == 0u) { xcd_barrier_complete(bar, b.x, nloc, nx); b.st[0] = nloc; b.st[1] = nx; }
        const unsigned old = xb_add(&bar[XB_XSUB(b.x)], 1u);
        const unsigned gen = old / nloc;
        if (old + 1u == (gen + 1u) * nloc) {
            __builtin_amdgcn_fence(__ATOMIC_RELEASE, "agent");
            asm volatile("s_waitcnt vmcnt(0)" ::: "memory");
            const unsigned og = xb_add(&bar[XB_TOP], 1u);
            const unsigned tg = og / nx;
            if (og + 1u == (tg + 1u) * nx) xb_add(&bar[XB_TOPGEN], 1u);
            else XB_SPIN(xb_ld(&bar[XB_TOPGEN]) == tg, bar);
            __builtin_amdgcn_fence(__ATOMIC_ACQUIRE, "agent");
            xb_add(&bar[XB_XGEN(b.x)], 1u);
            asm volatile("s_waitcnt vmcnt(0)" ::: "memory");
        } else {
            XB_SPIN(xb_ld(&bar[XB_XGEN(b.x)]) == gen, bar);
            __builtin_amdgcn_fence(__ATOMIC_ACQUIRE, "agent");
            asm volatile("s_waitcnt vmcnt(0)" ::: "memory");
        }
    }
    __syncthreads();
}

__device__ __forceinline__ float wave_sum(float v) {
#pragma unroll
    for (int o = 1; o < 64; o <<= 1) v += __shfl_xor(v, o);
    return v;
}
struct Ctx { LAS unsigned char* lds; int tid, lane, wave, G, bid; };

struct CvtJob { const float* src; bf16_t* dst; int K, N, sld, nbatch, mode; };
__device__ __forceinline__ int cvt_items(const CvtJob& J) { return J.nbatch * (J.K / 64) * (J.N / 32); }
__device__ __forceinline__ void cvt_item(const CvtJob& J, int item, LAS float* scr, int lane) {
    const int nblk = J.N / 32, per = (J.K / 64) * nblk, e = item / per, rem = item - e * per, kb = rem / nblk, nb = rem - kb * nblk, k0 = 64 * kb, n0 = 32 * nb;
    const float* W = J.src + (size_t)e * J.K * J.sld;
    const int drows = J.mode ? 2 * J.N : J.N;
    const int drow0 = J.mode ? (256 * (n0 >> 7) + (n0 & 127) + (J.mode == 2 ? 128 : 0)) : n0;
    bf16_t* WT = J.dst + ((size_t)e * drows + drow0) * J.K;
#pragma unroll 8
    for (int i = 0; i < 32; ++i) { const int kk = 2 * i + (lane >> 5); scr[kk * 33 + (lane & 31)] = W[(size_t)(k0 + kk) * J.sld + n0 + (lane & 31)]; }
    LDS_WAIT(); asm volatile("" ::: "memory");
    const int c = lane & 7;
#pragma unroll
    for (int j = 0; j < 4; ++j) { const int n = (lane >> 3) + 8 * j; const LAS float* s = scr + (8 * c) * 33 + n;
        u32x4 o; o.x = pk2(s[0 * 33], s[1 * 33]); o.y = pk2(s[2 * 33], s[3 * 33]); o.z = pk2(s[4 * 33], s[5 * 33]); o.w = pk2(s[6 * 33], s[7 * 33]);
        *(u32x4*)(WT + (size_t)n * J.K + k0 + 8 * c) = o; }
    LDS_WAIT(); asm volatile("" ::: "memory");
}
#define CVT_RUN(J) do { const int _n = cvt_items(J); for (; it < base + _n; it += NGW) cvt_item(J, it - base, scr, C.lane); base += _n; } while (0)

struct Params {
    const float* in[43]; const int* positions; float* out; unsigned char* ws; int step_lo, step_hi, pad0, pad1;
};

__device__ __forceinline__ void convert_pool_ffn(const Ctx& C, const Params& P, int ib  ) {
    LAS float* scr = (LAS float*)(C.lds + C.wave * 16384);
    bf16_t* WB = (bf16_t*)(P.ws + WS_WB);
    const int gw = C.bid * NWAVES + C.wave, NGW = C.G * NWAVES; int it = gw, base = 0;
    const CvtJob j0{P.in[ib + 0], WB + WB_MIX0, D, D, D, 1, 0};
    const CvtJob j1{P.in[ib + 1], WB + WB_MIX1, 256, 256, 256, 4, 0};
    const CvtJob j2{P.in[ib + 5], WB + WB_FFN0, D, FF, FF, 1, 1};
    const CvtJob j3{P.in[ib + 6], WB + WB_FFN0, D, FF, FF, 1, 2};
    const CvtJob j4{P.in[ib + 7], WB + WB_FFN1_DENSE, FF, D, D, 1, 0};
    CVT_RUN(j0); CVT_RUN(j1); CVT_RUN(j2); CVT_RUN(j3); CVT_RUN(j4);
}
__device__ __forceinline__ void convert_attn_moe(const Ctx& C, const Params& P, int ib) {
    LAS float* scr = (LAS float*)(C.lds + C.wave * 16384);
    bf16_t* WB = (bf16_t*)(P.ws + WS_WB);
    const int gw = C.bid * NWAVES + C.wave, NGW = C.G * NWAVES; int it = gw, base = 0;
    const CvtJob j0{P.in[ib + 0], WB + WB_MIX0, D, QKVW, QKVW, 1, 0};
    const CvtJob j1{P.in[ib + 1], WB + WB_MIX1, D, D, D, 1, 0};
    const CvtJob j2{P.in[ib + 5], WB + WB_FFN0, D, FFE, FFE, NE, 1};
    const CvtJob j3{P.in[ib + 6], WB + WB_FFN0, D, FFE, FFE, NE, 2};
    const CvtJob j4{P.in[ib + 7], WB + WB_FFN1_MOE, FFE, D, D, NE, 0};
    CVT_RUN(j0); CVT_RUN(j1); CVT_RUN(j2); CVT_RUN(j3); CVT_RUN(j4);
}
__device__ __forceinline__ void convert_conv_ffn(const Ctx& C, const Params& P, int ib) {
    LAS float* scr = (LAS float*)(C.lds + C.wave * 16384);
    bf16_t* WB = (bf16_t*)(P.ws + WS_WB);
    const int gw = C.bid * NWAVES + C.wave, NGW = C.G * NWAVES; int it = gw, base = 0;
    const CvtJob j0{P.in[ib + 0], WB + WB_MIX0, D, D, 3 * D, 1, 0};
    const CvtJob j1{P.in[ib + 0] + D, WB + WB_MIX0 + (size_t)D * D, D, D, 3 * D, 1, 1};
    const CvtJob j2{P.in[ib + 0] + 2 * D, WB + WB_MIX0 + (size_t)D * D, D, D, 3 * D, 1, 2};
    const CvtJob j3{P.in[ib + 2], WB + WB_MIX1, D, D, D, 1, 0};
    const CvtJob j4{P.in[ib + 5], WB + WB_FFN0, D, FF, FF, 1, 1};
    const CvtJob j5{P.in[ib + 6], WB + WB_FFN0, D, FF, FF, 1, 2};
    const CvtJob j6{P.in[ib + 7], WB + WB_FFN1_DENSE, FF, D, D, 1, 0};
    CVT_RUN(j0); CVT_RUN(j1); CVT_RUN(j2); CVT_RUN(j3); CVT_RUN(j4); CVT_RUN(j5); CVT_RUN(j6);
}
__device__ __forceinline__ void convert_pool_moe(const Ctx& C, const Params& P, int ib) {
    LAS float* scr = (LAS float*)(C.lds + C.wave * 16384);
    bf16_t* WB = (bf16_t*)(P.ws + WS_WB);
    const int gw = C.bid * NWAVES + C.wave, NGW = C.G * NWAVES; int it = gw, base = 0;
    const CvtJob j0{P.in[ib + 0], WB + WB_MIX0, D, D, D, 1, 0};
    const CvtJob j1{P.in[ib + 1], WB + WB_MIX1, 256, 256, 256, 4, 0};
    const CvtJob j2{P.in[ib + 6], WB + WB_FFN0, D, FFE, FFE, NE, 1};
    const CvtJob j3{P.in[ib + 7], WB + WB_FFN0, D, FFE, FFE, NE, 2};
    const CvtJob j4{P.in[ib + 8], WB + WB_FFN1_MOE, FFE, D, D, NE, 0};
    CVT_RUN(j0); CVT_RUN(j1); CVT_RUN(j2); CVT_RUN(j3); CVT_RUN(j4);
}

__device__ __forceinline__ void prologue_misc(const Ctx& C, const Params& P) {
    const int gt = C.bid * 512 + C.tid, NT = C.G * 512;
    float* cosT = (float*)(P.ws + WS_ROPE); float* sinT = cosT + (size_t)M * 8;
    for (int i = gt; i < M * 8; i += NT) {
        const int m = i >> 3, j = i & 7;
        const float invf = (float)exp2(-(double)j * 0.125 * 18.931568569324174);
        const float ang = (float)P.positions[m] * invf;
        double rev = (double)ang * 0.15915494309189535; rev -= floor(rev);
        const float rf = (float)rev;
        cosT[i] = __builtin_amdgcn_cosf(rf); sinT[i] = __builtin_amdgcn_sinf(rf);
    }
    const float* x = P.in[0]; bf16_t* XB = (bf16_t*)(P.ws + WS_XB);
    for (int i = gt; i < M * D / 8; i += NT) {
        const f32x4 a = *(const f32x4*)(x + (size_t)i * 8), b = *(const f32x4*)(x + (size_t)i * 8 + 4);
        u32x4 w; w.x = pk2(a[0], a[1]); w.y = pk2(a[2], a[3]); w.z = pk2(b[0], b[1]); w.w = pk2(b[2], b[3]);
        *(u32x4*)(XB + (size_t)i * 8) = w;
    }
}

__device__ __forceinline__ void pool_phase(const Ctx& C, const bf16_t* U, bf16_t* Pd) {
    const int gt = C.bid * 512 + C.tid, NT = C.G * 512;
    for (int i = gt; i < M * (D / 8); i += NT) {
        const int m = i >> 7, ch = i & 127, t = m & (SEQ - 1), w = 2 << (ch >> 5);
        const int cnt = (t + 1 < w) ? (t + 1) : w;
        float s[8];
#pragma unroll
        for (int j = 0; j < 8; ++j) s[j] = 0.f;
        const bf16_t* p = U + (size_t)m * D + ch * 8;
        u32x4 self = *(const u32x4*)p;
        for (int k = 0; k < cnt; ++k) { const u32x4 v = *(const u32x4*)(p - (size_t)k * D);
            s[0] += bflo(v.x); s[1] += bfhi(v.x); s[2] += bflo(v.y); s[3] += bfhi(v.y); s[4] += bflo(v.z); s[5] += bfhi(v.z); s[6] += bflo(v.w); s[7] += bfhi(v.w); }
        const float inv = 1.0f / (float)cnt;
        u32x4 o;
        o.x = pk2(s[0] * inv - bflo(self.x), s[1] * inv - bfhi(self.x)); o.y = pk2(s[2] * inv - bflo(self.y), s[3] * inv - bfhi(self.y));
        o.z = pk2(s[4] * inv - bflo(self.z), s[5] * inv - bfhi(self.z)); o.w = pk2(s[6] * inv - bflo(self.w), s[7] * inv - bfhi(self.w));
        *(u32x4*)(Pd + (size_t)m * D + ch * 8) = o;
    }
}
__device__ __forceinline__ void conv_phase(const Ctx& C, const bf16_t* Bb, const bf16_t* Z, const float* cw, bf16_t* Gd) {
    const int gt = C.bid * 512 + C.tid, NT = C.G * 512;
    for (int i = gt; i < M * (D / 8); i += NT) {
        const int m = i >> 7, ch = i & 127, t = m & (SEQ - 1);
        const size_t off = (size_t)m * D + ch * 8;
        const u32x4 z0 = *(const u32x4*)(Z + off);
        u32x4 z1 = {0u, 0u, 0u, 0u}, z2 = {0u, 0u, 0u, 0u};
        if (t >= 1) z1 = *(const u32x4*)(Z + off - D);
        if (t >= 2) z2 = *(const u32x4*)(Z + off - 2 * D);
        const u32x4 bb = *(const u32x4*)(Bb + off);
        const f32x4 w0a = *(const f32x4*)(cw + ch * 8), w0b = *(const f32x4*)(cw + ch * 8 + 4);
        const f32x4 w1a = *(const f32x4*)(cw + D + ch * 8), w1b = *(const f32x4*)(cw + D + ch * 8 + 4);
        const f32x4 w2a = *(const f32x4*)(cw + 2 * D + ch * 8), w2b = *(const f32x4*)(cw + 2 * D + ch * 8 + 4);
        float r[8];
        r[0] = bflo(bb.x) * (w0a[0] * bflo(z0.x) + w1a[0] * bflo(z1.x) + w2a[0] * bflo(z2.x));
        r[1] = bfhi(bb.x) * (w0a[1] * bfhi(z0.x) + w1a[1] * bfhi(z1.x) + w2a[1] * bfhi(z2.x));
        r[2] = bflo(bb.y) * (w0a[2] * bflo(z0.y) + w1a[2] * bflo(z1.y) + w2a[2] * bflo(z2.y));
        r[3] = bfhi(bb.y) * (w0a[3] * bfhi(z0.y) + w1a[3] * bfhi(z1.y) + w2a[3] * bfhi(z2.y));
        r[4] = bflo(bb.z) * (w0b[0] * bflo(z0.z) + w1b[0] * bflo(z1.z) + w2b[0] * bflo(z2.z));
        r[5] = bfhi(bb.z) * (w0b[1] * bfhi(z0.z) + w1b[1] * bfhi(z1.z) + w2b[1] * bfhi(z2.z));
        r[6] = bflo(bb.w) * (w0b[2] * bflo(z0.w) + w1b[2] * bflo(z1.w) + w2b[2] * bflo(z2.w));
        r[7] = bfhi(bb.w) * (w0b[3] * bfhi(z0.w) + w1b[3] * bfhi(z1.w) + w2b[3] * bfhi(z2.w));
        u32x4 o; o.x = pk2(r[0], r[1]); o.y = pk2(r[2], r[3]); o.z = pk2(r[4], r[5]); o.w = pk2(r[6], r[7]);
        *(u32x4*)(Gd + off) = o;
    }
}

template <int MODE, bool ROUTER>
__device__ __forceinline__ void ln_phase(const Ctx& C, const Params& P, const float* PRE  , const float* XF  , const float* gam, const float* bet, float* outF, bf16_t* outB, const float* wrouter) {
    const bf16_t* Y = (const bf16_t*)(P.ws + WS_AUX + AX_Y); const bf16_t* YP = (const bf16_t*)(P.ws + WS_BIG + BG_YP);
    const int* POS = (const int*)(P.ws + WS_MISC + MS_POS);
    int* SEL = (int*)(P.ws + WS_MISC + MS_SEL); float* GATE = (float*)(P.ws + WS_MISC + MS_GATE); unsigned* WGCNT = (unsigned*)(P.ws + WS_MISC + MS_WGCNT);
    LAS float* wr_lds = (LAS float*)C.lds;
    LAS unsigned* cnt_lds = (LAS unsigned*)(C.lds + 32768);
    const f32x4* g4 = (const f32x4*)gam + C.lane; const f32x4* b4 = (const f32x4*)bet + C.lane;
    f32x4 gv[4], bv[4];
#pragma unroll
    for (int j = 0; j < 4; ++j) { gv[j] = g4[64 * j]; bv[j] = b4[64 * j]; }
    if (ROUTER) {
        for (int k = C.tid; k < D; k += 512) { const f32x4 a = *(const f32x4*)(wrouter + (size_t)k * 8), b = *(const f32x4*)(wrouter + (size_t)k * 8 + 4);
            wr_lds[0 * D + k] = a[0]; wr_lds[1 * D + k] = a[1]; wr_lds[2 * D + k] = a[2]; wr_lds[3 * D + k] = a[3];
            wr_lds[4 * D + k] = b[0]; wr_lds[5 * D + k] = b[1]; wr_lds[6 * D + k] = b[2]; wr_lds[7 * D + k] = b[3]; }
    }
    for (int tb = C.bid; tb < M / 64; tb += C.G) {
        if (ROUTER) { if (C.tid < 8) cnt_lds[C.tid] = 0u; __syncthreads(); }
        for (int i = 0; i < 8; ++i) {
            const int row = tb * 64 + C.wave * 8 + i;
            f32x4 v[4];
            if (MODE == 0) { const f32x4* p = (const f32x4*)(PRE + (size_t)row * D) + C.lane;
#pragma unroll
                for (int j = 0; j < 4; ++j) v[j] = p[64 * j];
            } else {
                const int p0 = POS[2 * row], p1 = POS[2 * row + 1];
                const f32x4* p = (const f32x4*)(XF + (size_t)row * D) + C.lane;
#pragma unroll
                for (int j = 0; j < 4; ++j) v[j] = p[64 * j] * ALPHA;
#pragma unroll
                for (int sl = 0; sl < 2; ++sl) { const int ps = sl ? p1 : p0;
                    if (ps < 32768) { const u32x2* y = (const u32x2*)(Y + (size_t)ps * D) + C.lane;
#pragma unroll
                        for (int j = 0; j < 4; ++j) { const u32x2 a = y[64 * j]; v[j][0] += bflo(a.x); v[j][1] += bfhi(a.x); v[j][2] += bflo(a.y); v[j][3] += bfhi(a.y); }
                    } else { for (int kc = 0; kc < 7; ++kc) { const u32x2* y = (const u32x2*)(YP + ((size_t)kc * 2048 + (ps - 32768)) * D) + C.lane;
#pragma unroll
                        for (int j = 0; j < 4; ++j) { const u32x2 a = y[64 * j]; v[j][0] += bflo(a.x); v[j][1] += bfhi(a.x); v[j][2] += bflo(a.y); v[j][3] += bfhi(a.y); } } } }
            }
            float s = 0.f;
#pragma unroll
            for (int j = 0; j < 4; ++j) s += (v[j][0] + v[j][1]) + (v[j][2] + v[j][3]);
            const float mean = wave_sum(s) * (1.f / D); float s2 = 0.f;
#pragma unroll
            for (int j = 0; j < 4; ++j) { v[j] = v[j] - mean; s2 += (v[j][0] * v[j][0] + v[j][1] * v[j][1]) + (v[j][2] * v[j][2] + v[j][3] * v[j][3]); }
            const float rstd = 1.f / sqrtf(wave_sum(s2) * (1.f / D) + LN_EPS);
#pragma unroll
            for (int j = 0; j < 4; ++j) v[j] = v[j] * rstd * gv[j] + bv[j];
            f32x4* of = (f32x4*)(outF + (size_t)row * D) + C.lane;
#pragma unroll
            for (int j = 0; j < 4; ++j) of[64 * j] = v[j];
            if (outB) { u32x2* ob = (u32x2*)(outB + (size_t)row * D) + C.lane;
#pragma unroll
                for (int j = 0; j < 4; ++j) { u32x2 w; w.x = pk2(v[j][0], v[j][1]); w.y = pk2(v[j][2], v[j][3]); ob[64 * j] = w; } }
            if (ROUTER) {
                float lg[8];
#pragma unroll
                for (int e = 0; e < 8; ++e) { float a = 0.f;
#pragma unroll
                    for (int j = 0; j < 4; ++j) { const f32x4 w = *(const LAS f32x4*)(wr_lds + e * D + 256 * j + 4 * C.lane); a += (v[j][0] * w[0] + v[j][1] * w[1]) + (v[j][2] * w[2] + v[j][3] * w[3]); }
                    lg[e] = wave_sum(a); }
                int e0 = 0; float v0 = lg[0];
#pragma unroll
                for (int e = 1; e < 8; ++e) if (lg[e] > v0) { v0 = lg[e]; e0 = e; }
                int e1 = -1; float v1 = -3.0e38f;
#pragma unroll
                for (int e = 0; e < 8; ++e) if (e != e0 && lg[e] > v1) { v1 = lg[e]; e1 = e; }
                const float g1 = 1.0f / (1.0f + __expf(v0 - v1)), g0 = 1.0f - g1;
                if (C.lane == 0) { SEL[2 * row] = e0; SEL[2 * row + 1] = e1; GATE[2 * row] = g0; GATE[2 * row + 1] = g1;
                    atomicAdd((unsigned*)(cnt_lds + e0), 1u); atomicAdd((unsigned*)(cnt_lds + e1), 1u); }
            }
        }
        if (ROUTER) { __syncthreads(); if (C.tid < 8) WGCNT[tb * 8 + C.tid] = cnt_lds[C.tid]; __syncthreads(); }
    }
}

__device__ __forceinline__ void moe_gather_phase(const Ctx& C, const Params& P) {
    const int* SEL = (const int*)(P.ws + WS_MISC + MS_SEL); const float* GATE = (const float*)(P.ws + WS_MISC + MS_GATE); const unsigned* WGCNT = (const unsigned*)(P.ws + WS_MISC + MS_WGCNT);
    int* POS = (int*)(P.ws + WS_MISC + MS_POS); int* OFF = (int*)(P.ws + WS_MISC + MS_OFF); float* ROWGATE = (float*)(P.ws + WS_MISC + MS_ROWGATE);
    const bf16_t* XB = (const bf16_t*)(P.ws + WS_XB); bf16_t* XP = (bf16_t*)(P.ws + WS_AUX + AX_XPERM);
    LAS unsigned* part = (LAS unsigned*)C.lds;
    LAS int* tot = (LAS int*)(C.lds + 4096);
    LAS int* ppos = (LAS int*)(C.lds + 8192);
    for (int tb = C.bid; tb < M / 64; tb += C.G) {
        { const int e = C.tid & 7, q = C.tid >> 3; unsigned t = 0, bfr = 0;
#pragma unroll
          for (int k = 0; k < 4; ++k) { const int b2 = 4 * q + k; const unsigned c = WGCNT[b2 * 8 + e]; t += c; bfr += (b2 < tb) ? c : 0u; }
          part[q * 8 + e] = t; part[512 + q * 8 + e] = bfr; }
        __syncthreads();
        if (C.tid < 8) { unsigned t = 0, bfr = 0; for (int q = 0; q < 64; ++q) { t += part[q * 8 + C.tid]; bfr += part[512 + q * 8 + C.tid]; } tot[C.tid] = (int)t; tot[8 + C.tid] = (int)bfr; }
        __syncthreads();
        if (C.tid == 0) { int o = 0; for (int e = 0; e < 8; ++e) { tot[16 + e] = o; o += (tot[e] + 255) & ~255; } tot[24] = o; }
        __syncthreads();
        if (tb == 0 && C.tid < 9) OFF[C.tid] = tot[16 + C.tid];
        if (C.wave == 0) {
            const int row = tb * 64 + C.lane; const int e0 = SEL[2 * row], e1 = SEL[2 * row + 1];
            int p0 = 0, p1 = 0;
            const unsigned long long lt = (1ull << C.lane) - 1ull;
#pragma unroll
            for (int e = 0; e < 8; ++e) { const unsigned long long m0 = __ballot(e0 == e), m1 = __ballot(e1 == e);
                const int bs = tot[16 + e] + tot[8 + e]; const int n0 = __popcll(m0);
                if (e0 == e) p0 = bs + __popcll(m0 & lt);
                if (e1 == e) p1 = bs + n0 + __popcll(m1 & lt); }
            POS[2 * row] = p0; POS[2 * row + 1] = p1; ppos[2 * C.lane] = p0; ppos[2 * C.lane + 1] = p1;
            ROWGATE[p0] = GATE[2 * row]; ROWGATE[p1] = GATE[2 * row + 1];
        }
        __syncthreads();
        for (int k = 0; k < 16; ++k) { const int pr = C.wave * 16 + k; const int row = tb * 64 + (pr >> 1); const int dst = ppos[pr];
            const u32x4* s = (const u32x4*)(XB + (size_t)row * D) + C.lane; u32x4* d = (u32x4*)(XP + (size_t)dst * D) + C.lane;
            d[0] = s[0]; d[64] = s[64]; }
        for (int e = 0; e < 8; ++e) { const int ps = tot[16 + e] + tot[e], pe = tot[16 + e + 1];
            for (int r = ps + (tb * NWAVES + C.wave); r < pe; r += (M / 64) * NWAVES) { u32x4* d = (u32x4*)(XP + (size_t)r * D) + C.lane; d[0] = (u32x4){0u, 0u, 0u, 0u}; d[64] = (u32x4){0u, 0u, 0u, 0u}; if (C.lane == 0) ROWGATE[r] = 0.f; } }
        __syncthreads();
    }
}

__device__ __forceinline__ int crow(int r, int hi) { return (r & 3) + 8 * (r >> 2) + 4 * hi; }
__device__ __forceinline__ s16x4 vtr(const LAS unsigned char* p) { typedef short v4i16_t __attribute__((ext_vector_type(4))); return __builtin_bit_cast(s16x4, __builtin_amdgcn_ds_read_tr16_b64_v4i16((LAS v4i16_t*)p)); }
__device__ __forceinline__ void attn_unit(LAS unsigned char* wl  , const bf16_t* QKV, bf16_t* OG, float* LSE, int g, int dil, int b, int h, int r, int qb, int lane) {
    const int r32 = lane & 31, hi = lane >> 5, q0 = qb * 32;
    const bf16_t* base = QKV + (size_t)(b * SEQ + r) * QKVW + g * 3072 + h * 64;
    const size_t rs = (size_t)dil * QKVW;
    LAS float* wsf = (LAS float*)(wl + 4096);
    bf16x8 qr[4];
    { const bf16_t* qp = base + (size_t)(q0 + r32) * rs + 8 * hi;
#pragma unroll
      for (int d0 = 0; d0 < 4; ++d0) qr[d0] = *(const bf16x8*)(qp + 16 * d0); }
    f32x16 o0, o1;
#pragma unroll
    for (int i = 0; i < 16; ++i) { o0[i] = 0.f; o1[i] = 0.f; }
    float mrow = -INFINITY, lrow = 0.f;
    const int kt0 = qb >= 4 ? qb - 4 : 0;
    const int vb = ((lane >> 4) & 1) * 32 + (lane & 3) * 8 + (4 * hi + ((lane & 15) >> 2)) * 64;
    for (int kt = kt0; kt <= qb; ++kt) {
        bf16x8 kf[4]; u32x4 vv[4];
        { const bf16_t* kp = base + 1024 + (size_t)(32 * kt + r32) * rs + 8 * hi;
#pragma unroll
          for (int d0 = 0; d0 < 4; ++d0) kf[d0] = *(const bf16x8*)(kp + 16 * d0);
          const bf16_t* vp = base + 2048 + (size_t)(32 * kt + (lane >> 1)) * rs + 32 * (lane & 1);
#pragma unroll
          for (int c = 0; c < 4; ++c) vv[c] = *(const u32x4*)(vp + 8 * c); }
        f32x16 p;
#pragma unroll
        for (int i = 0; i < 16; ++i) p[i] = 0.f;
#pragma unroll
        for (int d0 = 0; d0 < 4; ++d0) p = __builtin_amdgcn_mfma_f32_32x32x16_bf16(kf[d0], qr[d0], p, 0, 0, 0);
        if (kt == qb || kt == qb - 4) {
            const int q = q0 + r32;
#pragma unroll
            for (int i = 0; i < 16; ++i) { const int key = 32 * kt + crow(i, hi); if (key > q || key < q - 128) p[i] = -INFINITY; }
        }
        float mx = p[0];
#pragma unroll
        for (int i = 1; i < 16; ++i) mx = fmaxf(mx, p[i]);
        mx = fmaxf(mx, __shfl_xor(mx, 32));
        const float mnew = fmaxf(mrow, mx);
        const float alpha = __builtin_amdgcn_exp2f(mrow - mnew);
        mrow = mnew;
        float ps = 0.f;
#pragma unroll
        for (int i = 0; i < 16; ++i) { p[i] = __builtin_amdgcn_exp2f(p[i] - mnew); ps += p[i]; }
        lrow = lrow * alpha + ps;
        { const int key = lane >> 1, blk = ((key >> 4) * 2 + (lane & 1)) * 1024 + (key & 15) * 64;
#pragma unroll
          for (int c = 0; c < 4; ++c) *(LAS u32x4*)(wl + blk + 16 * c) = vv[c];
          if (hi == 0) wsf[r32] = alpha; }
        LDS_WAIT(); asm volatile("" ::: "memory");
#pragma unroll
        for (int i = 0; i < 16; ++i) { const float a = wsf[crow(i, hi)]; o0[i] *= a; o1[i] *= a; }
        u32x4 pw0, pw1;
        pw0.x = cvt_pk_bf16(p[0], p[1]); pw0.y = cvt_pk_bf16(p[2], p[3]); pw0.z = cvt_pk_bf16(p[4], p[5]); pw0.w = cvt_pk_bf16(p[6], p[7]);
        pw1.x = cvt_pk_bf16(p[8], p[9]); pw1.y = cvt_pk_bf16(p[10], p[11]); pw1.z = cvt_pk_bf16(p[12], p[13]); pw1.w = cvt_pk_bf16(p[14], p[15]);
#pragma unroll
        for (int ks = 0; ks < 2; ++ks) {
            const bf16x8 pa = __builtin_bit_cast(bf16x8, ks == 0 ? pw0 : pw1);
            { const s16x4 lo = vtr(wl + (ks * 2 + 0) * 1024 + vb), hh = vtr(wl + (ks * 2 + 0) * 1024 + vb + 512);
              const bf16x8 vf = {lo[0], lo[1], lo[2], lo[3], hh[0], hh[1], hh[2], hh[3]};
              o0 = __builtin_amdgcn_mfma_f32_32x32x16_bf16(pa, vf, o0, 0, 0, 0); }
            { const s16x4 lo = vtr(wl + (ks * 2 + 1) * 1024 + vb), hh = vtr(wl + (ks * 2 + 1) * 1024 + vb + 512);
              const bf16x8 vf = {lo[0], lo[1], lo[2], lo[3], hh[0], hh[1], hh[2], hh[3]};
              o1 = __builtin_amdgcn_mfma_f32_32x32x16_bf16(pa, vf, o1, 0, 0, 0); }
        }
        LDS_WAIT(); asm volatile("" ::: "memory");
    }
    const float ltot = lrow + __shfl_xor(lrow, 32);
    if (hi == 0) { wsf[r32] = 1.0f / ltot;
        LSE[(size_t)(b * SEQ + (q0 + r32) * dil + r) * 16 + h] = mrow + __log2f(ltot); }
    LDS_WAIT(); asm volatile("" ::: "memory");
    LAS bf16_t* stg = (LAS bf16_t*)wl;
#pragma unroll
    for (int i = 0; i < 16; ++i) { const int orow = crow(i, hi); const float inv = wsf[orow];
        stg[orow * 64 + r32] = (bf16_t)f2bf(o0[i] * inv); stg[orow * 64 + 32 + r32] = (bf16_t)f2bf(o1[i] * inv); }
    LDS_WAIT(); asm volatile("" ::: "memory");
#pragma unroll
    for (int i = 0; i < 4; ++i) { const int row = i * 8 + (lane >> 3), ch = lane & 7; const u32x4 v = *(const LAS u32x4*)(stg + row * 64 + ch * 8);
        *(u32x4*)(OG + (size_t)(b * SEQ + (q0 + row) * dil + r) * D + h * 64 + ch * 8) = v; }
    LDS_WAIT(); asm volatile("" ::: "memory");
}
__device__ __forceinline__ void attn_phase(const Ctx& C, const Params& P) {
    const bf16_t* QKV = (const bf16_t*)(P.ws + WS_BIG + BG_QKV);
    LAS unsigned char* wl = C.lds + C.wave * 4608;
    const int gw = C.bid * NWAVES + C.wave, NGW = C.G * NWAVES;
    for (int i = 0; ; ++i) {
        const int uidx = i * NGW + gw; if (uidx >= 3 * 8192) break;
        const int g = uidx >> 13, j = uidx & 8191;
        const int dil = (g == 0) ? 1 : (g == 1 ? 4 : 16), lg = (g == 0) ? 6 : (g == 1 ? 4 : 2);
        const int nqb = 1 << lg, seq = j >> lg, qb = ((j & (nqb - 1)) + (i & 3) * (nqb >> 2)) & (nqb - 1);
        const int r = seq % dil, bh = seq / dil, h = bh & 15, b = bh >> 4;
        bf16_t* OG = (bf16_t*)(P.ws + WS_AUX + AX_OG) + (size_t)g * M * D; float* LSE = (float*)(P.ws + WS_AUX + AX_LSE) + (size_t)g * M * 16;
        attn_unit(wl, QKV, OG, LSE, g, dil, b, h, r, qb, C.lane);
    }
}
__device__ __forceinline__ void combine_phase(const Ctx& C, const Params& P) {
    const bf16_t* OG = (const bf16_t*)(P.ws + WS_AUX + AX_OG); const float* LSE = (const float*)(P.ws + WS_AUX + AX_LSE); bf16_t* ATT = (bf16_t*)(P.ws + WS_AUX + AX_ATT);
    const int gt = C.bid * 512 + C.tid, NT = C.G * 512;
    for (int i = gt; i < M * (D / 8); i += NT) {
        const int m = i >> 7, ch = i & 127, h = ch >> 3;
        const float l0 = LSE[(size_t)m * 16 + h], l1 = LSE[(size_t)(M + m) * 16 + h], l2 = LSE[(size_t)(2 * M + m) * 16 + h];
        const float mx = fmaxf(l0, fmaxf(l1, l2));
        float w0 = __builtin_amdgcn_exp2f(l0 - mx), w1 = __builtin_amdgcn_exp2f(l1 - mx), w2 = __builtin_amdgcn_exp2f(l2 - mx);
        const float inv = 1.0f / (w0 + w1 + w2); w0 *= inv; w1 *= inv; w2 *= inv;
        const size_t off = (size_t)m * D + ch * 8;
        const u32x4 a = *(const u32x4*)(OG + off), b = *(const u32x4*)(OG + (size_t)M * D + off), c = *(const u32x4*)(OG + (size_t)2 * M * D + off);
        u32x4 o;
        o.x = pk2(w0 * bflo(a.x) + w1 * bflo(b.x) + w2 * bflo(c.x), w0 * bfhi(a.x) + w1 * bfhi(b.x) + w2 * bfhi(c.x));
        o.y = pk2(w0 * bflo(a.y) + w1 * bflo(b.y) + w2 * bflo(c.y), w0 * bfhi(a.y) + w1 * bfhi(b.y) + w2 * bfhi(c.y));
        o.z = pk2(w0 * bflo(a.z) + w1 * bflo(b.z) + w2 * bflo(c.z), w0 * bfhi(a.z) + w1 * bfhi(b.z) + w2 * bfhi(c.z));
        o.w = pk2(w0 * bflo(a.w) + w1 * bflo(b.w) + w2 * bflo(c.w), w0 * bfhi(a.w) + w1 * bfhi(b.w) + w2 * bfhi(c.w));
        *(u32x4*)(ATT + off) = o;
    }
}


#if MK_CHECK
__device__ __forceinline__ unsigned hsh(unsigned x) { x ^= x >> 16; x *= 0x7feb352dU; x ^= x >> 15; x *= 0x846ca68bU; x ^= x >> 16; return x; }
__device__ __forceinline__ float rbf(float x) { return bf2f(f2bf(x)); }
__device__ __forceinline__ void chk_acc(const Params& P, int p, float e2, float r2) {
    e2 = wave_sum(e2); r2 = wave_sum(r2);
    if ((threadIdx.x & 63) == 0) { float* w = (float*)(P.ws + WS_CTL) + CW_CHK + 2 * p; atomicAdd(w, e2); atomicAdd(w + 1, r2); }
}
#define CHK_BEGIN(NS) const int gt = C.bid * 512 + C.tid, NT = C.G * 512; float e2 = 0.f, r2 = 0.f; for (int s_ = gt; s_ < (NS); s_ += NT) { const unsigned h1 = hsh(2u * (unsigned)s_ + 0x9e3779b9u * (unsigned)(p + 1)), h2 = hsh(h1 + 0x85ebca6bu); (void)h2;
#define CHK_CMP(got, ref) do { const float _g = (got), _r = (ref); const float _d = _g - _r; e2 += (_d == _d) ? _d * _d : 1e30f; r2 += _r * _r; } while (0)
#define CHK_END() } chk_acc(P, p, e2, r2);
__device__ __forceinline__ float dot_aw(const bf16_t* a, const float* w, int K, int ldw) { float s = 0.f; for (int k = 0; k < K; ++k) s += bf2f(a[k]) * rbf(w[(size_t)k * ldw]); return s; }

__device__ __forceinline__ void chk_gemm_bf16(const Ctx& C, const Params& P, int p, const bf16_t* A, int lda, const float* W, int ldw, int K, const bf16_t* O, int ldo, int N) {
    CHK_BEGIN(16384) const int m = h1 % M, n = h2 % N; CHK_CMP(bf2f(O[(size_t)m * ldo + n]), dot_aw(A + (size_t)m * lda, W + n, K, ldw)); CHK_END()
}
__device__ __forceinline__ void chk_gemm_pre(const Ctx& C, const Params& P, int p, const bf16_t* A, int lda, int K, int grouped, const float* W, int ldw, const float* X, const float* scale, const float* O) {
    CHK_BEGIN(16384) const int m = h1 % M, n = h2 % D; const int g = n >> 8;
    const float d = grouped ? dot_aw(A + (size_t)m * lda + g * 256, W + (size_t)g * 256 * 256 + (n & 255), 256, 256) : dot_aw(A + (size_t)m * lda, W + n, K, ldw);
    CHK_CMP(O[(size_t)m * D + n], ALPHA * X[(size_t)m * D + n] + (scale ? scale[n] : 1.f) * d); CHK_END()
}
__device__ __forceinline__ void chk_swiglu(const Ctx& C, const Params& P, int p, const bf16_t* A, const float* Wg, const float* Wu, const bf16_t* O) {
    CHK_BEGIN(16384) const int m = h1 % M, n = h2 % FF; const float a = dot_aw(A + (size_t)m * D, Wg + n, D, FF), b = dot_aw(A + (size_t)m * D, Wu + n, D, FF);
    CHK_CMP(bf2f(O[(size_t)m * FF + n]), (a / (1.f + expf(-a))) * b); CHK_END()
}
__device__ __forceinline__ void chk_ln(const Ctx& C, const Params& P, int p, const float* PREb, const float* gam, const float* bet, const float* OF, const bf16_t* OB) {
    CHK_BEGIN(4096) const int m = h1 % M, n = h2 % D; const float* r = PREb + (size_t)m * D; float s = 0.f; for (int k = 0; k < D; ++k) s += r[k]; const float mean = s / D; float q = 0.f; for (int k = 0; k < D; ++k) { const float d = r[k] - mean; q += d * d; }
    const float ref = (r[n] - mean) / sqrtf(q / D + LN_EPS) * gam[n] + bet[n]; CHK_CMP(OF[(size_t)m * D + n], ref); if (OB) CHK_CMP(bf2f(OB[(size_t)m * D + n]), ref); CHK_END()
}
__device__ __forceinline__ void chk_pool(const Ctx& C, const Params& P, int p, const bf16_t* U, const bf16_t* Pd) {
    CHK_BEGIN(32768) const int m = h1 % M, n = h2 % D, t = m & (SEQ - 1), w = 2 << (n >> 8); const int cnt = t + 1 < w ? t + 1 : w; float s = 0.f; for (int k = 0; k < cnt; ++k) s += bf2f(U[(size_t)(m - k) * D + n]);
    CHK_CMP(bf2f(Pd[(size_t)m * D + n]), s / cnt - bf2f(U[(size_t)m * D + n])); CHK_END()
}
__device__ __forceinline__ void chk_rope_xb(const Ctx& C, const Params& P, int p) {
    const float* cosT = (const float*)(P.ws + WS_ROPE); const float* sinT = cosT + (size_t)M * 8; const bf16_t* XB = (const bf16_t*)(P.ws + WS_XB);
    CHK_BEGIN(32768) const int m = h1 % M, j = h2 & 7, n = h2 % D; const float invf = powf(500000.0f, -(float)j / 8.0f); const double ang = (double)((float)P.positions[m] * invf);
    CHK_CMP(cosT[m * 8 + j], (float)cos(ang)); CHK_CMP(sinT[m * 8 + j], (float)sin(ang)); CHK_CMP(bf2f(XB[(size_t)m * D + n]), P.in[0][(size_t)m * D + n]); CHK_END()
}
__device__ __forceinline__ void chk_qkv(const Ctx& C, const Params& P, int p, const bf16_t* A, const float* W, const bf16_t* O) {
    const float* cosT = (const float*)(P.ws + WS_ROPE); const float* sinT = cosT + (size_t)M * 8;
    CHK_BEGIN(16384) const int m = h1 % M, c = h2 % QKVW, kind = (c % 3072) >> 10, d = c & 63; const bf16_t* a = A + (size_t)m * D; float ref;
    if (kind < 2 && d < 16) { const int c1 = c - d + (d & 7), c2 = c1 + 8; const float r1 = dot_aw(a, W + c1, D, QKVW), r2 = dot_aw(a, W + c2, D, QKVW), cs = cosT[m * 8 + (d & 7)], sn = sinT[m * 8 + (d & 7)];
        ref = d < 8 ? r1 * cs - r2 * sn : r1 * sn + r2 * cs; } else ref = dot_aw(a, W + c, D, QKVW);
    if (kind == 0) ref *= QSCALE; CHK_CMP(bf2f(O[(size_t)m * QKVW + c]), ref); CHK_END()
}
__device__ __forceinline__ void chk_attn(const Ctx& C, const Params& P, int p) {
    const bf16_t* QKV = (const bf16_t*)(P.ws + WS_BIG + BG_QKV); const bf16_t* OG = (const bf16_t*)(P.ws + WS_AUX + AX_OG); const float* LSE = (const float*)(P.ws + WS_AUX + AX_LSE);
    CHK_BEGIN(8192) const int m = h1 % M, g = (h1 >> 16) % 3, h = h2 & 15, d = (h2 >> 4) & 63, dil = g == 0 ? 1 : (g == 1 ? 4 : 16), t = m & (SEQ - 1);
    const bf16_t* q = QKV + (size_t)m * QKVW + g * 3072 + h * 64; float mx = -INFINITY;
    for (int j = 0; j <= 128; ++j) { const int tk = t - j * dil; if (tk < 0) break; const bf16_t* k = QKV + (size_t)(m - j * dil) * QKVW + g * 3072 + 1024 + h * 64; float sc = 0.f; for (int e = 0; e < 64; ++e) sc += bf2f(q[e]) * bf2f(k[e]); mx = fmaxf(mx, sc); }
    float l = 0.f, o = 0.f;
    for (int j = 0; j <= 128; ++j) { const int tk = t - j * dil; if (tk < 0) break; const bf16_t* k = QKV + (size_t)(m - j * dil) * QKVW + g * 3072 + 1024 + h * 64; float sc = 0.f; for (int e = 0; e < 64; ++e) sc += bf2f(q[e]) * bf2f(k[e]);
        const float w = exp2f(sc - mx); l += w; o += w * bf2f(k[1024 + d]); }
    CHK_CMP(bf2f(OG[((size_t)g * M + m) * D + h * 64 + d]), o / l); CHK_CMP(LSE[((size_t)g * M + m) * 16 + h], mx + log2f(l)); CHK_END()
}
__device__ __forceinline__ void chk_combine(const Ctx& C, const Params& P, int p) {
    const bf16_t* OG = (const bf16_t*)(P.ws + WS_AUX + AX_OG); const float* LSE = (const float*)(P.ws + WS_AUX + AX_LSE); const bf16_t* ATT = (const bf16_t*)(P.ws + WS_AUX + AX_ATT);
    CHK_BEGIN(32768) const int m = h1 % M, n = h2 % D, h = n >> 6; float l[3], mx = -INFINITY; for (int g = 0; g < 3; ++g) { l[g] = LSE[((size_t)g * M + m) * 16 + h]; mx = fmaxf(mx, l[g]); }
    float sw = 0.f, o = 0.f; for (int g = 0; g < 3; ++g) { const float w = exp2f(l[g] - mx); sw += w; o += w * bf2f(OG[((size_t)g * M + m) * D + n]); }
    CHK_CMP(bf2f(ATT[(size_t)m * D + n]), o / sw); CHK_END()
}
__device__ __forceinline__ void chk_router(const Ctx& C, const Params& P, int p, const float* XFn, const float* Wr) {
    const int* SEL = (const int*)(P.ws + WS_MISC + MS_SEL); const float* GATE = (const float*)(P.ws + WS_MISC + MS_GATE);
    CHK_BEGIN(4096) const int m = h1 % M; float lg[8]; for (int e = 0; e < 8; ++e) lg[e] = 0.f; for (int k = 0; k < D; ++k) { const float xv = XFn[(size_t)m * D + k]; for (int e = 0; e < 8; ++e) lg[e] += xv * Wr[k * 8 + e]; }
    const int e0 = SEL[2 * m], e1 = SEL[2 * m + 1]; float bad = 0.f; if (e0 == e1 || e0 < 0 || e0 > 7 || e1 < 0 || e1 > 7) bad = 1.f; else { for (int e = 0; e < 8; ++e) { if (e != e0 && lg[e] > lg[e0] + 1e-3f) bad = 1.f; if (e != e0 && e != e1 && lg[e] > lg[e1] + 1e-3f) bad = 1.f; }
        const float g1 = 1.f / (1.f + expf(lg[e0] - lg[e1])); if (fabsf(GATE[2 * m + 1] - g1) > 2e-3f || fabsf(GATE[2 * m] - (1.f - g1)) > 2e-3f) bad = 1.f; }
    CHK_CMP(bad, 0.f); r2 += 1.f; CHK_END()
}
__device__ __forceinline__ void chk_gather(const Ctx& C, const Params& P, int p) {
    const int* SEL = (const int*)(P.ws + WS_MISC + MS_SEL); const float* GATE = (const float*)(P.ws + WS_MISC + MS_GATE); const int* POS = (const int*)(P.ws + WS_MISC + MS_POS); const int* OFF = (const int*)(P.ws + WS_MISC + MS_OFF);
    const float* ROWGATE = (const float*)(P.ws + WS_MISC + MS_ROWGATE); const bf16_t* XB = (const bf16_t*)(P.ws + WS_XB); const bf16_t* XP = (const bf16_t*)(P.ws + WS_AUX + AX_XPERM);
    CHK_BEGIN(32768) const int m = h1 % M, sl = (h1 >> 20) & 1, n = h2 % D, e = SEL[2 * m + sl], pos = POS[2 * m + sl]; float bad = 0.f;
    if (pos < OFF[e] || pos >= OFF[e + 1] || (OFF[e] & 255) || OFF[8] > MOE_ROWS_MAX || OFF[8] < 32768) bad = 1.f; else { if (XP[(size_t)pos * D + n] != XB[(size_t)m * D + n]) bad = 1.f; if (ROWGATE[pos] != GATE[2 * m + sl]) bad = 1.f; }
    CHK_CMP(bad, 0.f); r2 += 1.f; CHK_END()
}
__device__ __forceinline__ void chk_moe_up(const Ctx& C, const Params& P, int p, const float* Wg, const float* Wu) {
    const int* SEL = (const int*)(P.ws + WS_MISC + MS_SEL); const int* POS = (const int*)(P.ws + WS_MISC + MS_POS); const bf16_t* XP = (const bf16_t*)(P.ws + WS_AUX + AX_XPERM); const bf16_t* H = (const bf16_t*)(P.ws + WS_BIG + BG_HID);
    CHK_BEGIN(16384) const int m = h1 % M, sl = (h1 >> 20) & 1, n = h2 % FFE, e = SEL[2 * m + sl] & 7, pos = POS[2 * m + sl]; const bf16_t* a = XP + (size_t)pos * D;
    const float x = dot_aw(a, Wg + (size_t)e * D * FFE + n, D, FFE), y = dot_aw(a, Wu + (size_t)e * D * FFE + n, D, FFE); CHK_CMP(bf2f(H[(size_t)pos * FFE + n]), (x / (1.f + expf(-x))) * y); CHK_END()
}
__device__ __forceinline__ float moe_y(const Params& P, int pos, int n) {
    const bf16_t* Y = (const bf16_t*)(P.ws + WS_AUX + AX_Y); const bf16_t* YP = (const bf16_t*)(P.ws + WS_BIG + BG_YP);
    if (pos < 32768) return bf2f(Y[(size_t)pos * D + n]); float s = 0.f; for (int kc = 0; kc < 7; ++kc) s += bf2f(YP[((size_t)kc * 2048 + (pos - 32768)) * D + n]); return s; }
__device__ __forceinline__ void chk_moe_down(const Ctx& C, const Params& P, int p, const float* Wd) {
    const int* SEL = (const int*)(P.ws + WS_MISC + MS_SEL); const int* POS = (const int*)(P.ws + WS_MISC + MS_POS); const float* GATE = (const float*)(P.ws + WS_MISC + MS_GATE); const bf16_t* H = (const bf16_t*)(P.ws + WS_BIG + BG_HID); const bf16_t* Y = (const bf16_t*)(P.ws + WS_AUX + AX_Y);
    CHK_BEGIN(16384) const int m = h1 % M, sl = (h1 >> 20) & 1, n = h2 % D, e = SEL[2 * m + sl] & 7, pos = POS[2 * m + sl];
    CHK_CMP(moe_y(P, pos, n), GATE[2 * m + sl] * dot_aw(H + (size_t)pos * FFE, Wd + (size_t)e * FFE * D + n, FFE, D)); CHK_END()
}
__device__ __forceinline__ void chk_ln_moe(const Ctx& C, const Params& P, int p, const float* RS, const float* gam, const float* bet, const float* OF, const bf16_t* OB) {
    const int* POS = (const int*)(P.ws + WS_MISC + MS_POS);
    CHK_BEGIN(2048) const int m = h1 % M, n = h2 % D; const float* r = RS + (size_t)m * D; const int q0 = POS[2 * m], q1 = POS[2 * m + 1];
    float s = 0.f; for (int k = 0; k < D; ++k) s += ALPHA * r[k] + moe_y(P, q0, k) + moe_y(P, q1, k); const float mean = s / D; float q = 0.f; for (int k = 0; k < D; ++k) { const float d = ALPHA * r[k] + moe_y(P, q0, k) + moe_y(P, q1, k) - mean; q += d * d; }
    const float ref = (ALPHA * r[n] + moe_y(P, q0, n) + moe_y(P, q1, n) - mean) / sqrtf(q / D + LN_EPS) * gam[n] + bet[n]; CHK_CMP(OF[(size_t)m * D + n], ref); if (OB) CHK_CMP(bf2f(OB[(size_t)m * D + n]), ref); CHK_END()
}
__device__ __forceinline__ void chk_convin(const Ctx& C, const Params& P, int p, const bf16_t* A, const float* W, const bf16_t* Bb, const bf16_t* Z) {
    CHK_BEGIN(16384) const int m = h1 % M, n = h2 % D; const bf16_t* a = A + (size_t)m * D;
    if (h1 & 0x100000) CHK_CMP(bf2f(Bb[(size_t)m * D + n]), dot_aw(a, W + n, D, 3 * D)); else CHK_CMP(bf2f(Z[(size_t)m * D + n]), dot_aw(a, W + D + n, D, 3 * D) * dot_aw(a, W + 2 * D + n, D, 3 * D)); CHK_END()
}
__device__ __forceinline__ void chk_conv(const Ctx& C, const Params& P, int p, const bf16_t* Bb, const bf16_t* Z, const float* cw, const bf16_t* Gd) {
    CHK_BEGIN(32768) const int m = h1 % M, n = h2 % D, t = m & (SEQ - 1); float s = 0.f; for (int j = 0; j < 3; ++j) if (t - j >= 0) s += cw[j * D + n] * bf2f(Z[(size_t)(m - j) * D + n]);
    CHK_CMP(bf2f(Gd[(size_t)m * D + n]), bf2f(Bb[(size_t)m * D + n]) * s); CHK_END()
}
#endif

constexpr int NPHASE = 32;
constexpr int SMUL = MK_CHECK ? 2 : 1;
constexpr int NSTEPS = NPHASE * SMUL + (MK_CHECK ? 1 : 0);

__global__ void __launch_bounds__(NWAVES * 64, 2) hybrid_fwd(Params P) {
    extern __shared__ __attribute__((aligned(16))) unsigned char lds_raw[];
    Ctx C; C.lds = (LAS unsigned char*)lds_raw; C.tid = threadIdx.x; C.lane = C.tid & 63; C.wave = __builtin_amdgcn_readfirstlane(C.tid >> 6); C.G = gridDim.x; C.bid = blockIdx.x;
    volatile LAS unsigned* MISCW = (volatile LAS unsigned*)(C.lds + MISC_OFF);
    unsigned* ctl = (unsigned*)(P.ws + WS_CTL);
    for (int u = C.tid; u < (LDS_BYTES - LDSCTL_OFF) / 4; u += NWAVES * 64) ((LAS unsigned*)(C.lds + LDSCTL_OFF))[u] = 0u;
    __syncthreads();
    XcdBarrier bar; bar.bar = ctl + CW_BAR; bar.x = 0; bar.st = nullptr;
    if (!MK_PER_PHASE) bar = xcd_barrier_post(ctl + CW_BAR, MISCW + 8);
    const int lo = P.step_lo, hi = P.step_hi;
#define IN(k) (lo <= (k) && (k) < hi)
#define SEAM(k) do { if (IN(k) && IN((k) + 1)) { if (MK_PER_PHASE) { if (C.tid == 0) __hip_atomic_store(ctl + 1, 0xBADu, __ATOMIC_RELAXED, __HIP_MEMORY_SCOPE_AGENT); } else xcd_barrier(bar); } } while (0)
#if MK_CHECK
#define CHECK(p, stmt) do { if (IN(2 * (p) + 1)) { stmt; } SEAM(2 * (p) + 1); } while (0)
#else
#define CHECK(p, stmt) do { } while (0)
#endif
#define PH(p) (SMUL * (p))
#define REP(p) (((MK_REP_MASK) >> (p)) & 1ull)
#define PHASE(p, ...) do { if (IN(PH(p))) { { const int rep_pass = 0; (void)rep_pass; __VA_ARGS__ } if (REP(p)) { xcd_barrier(bar); { const int rep_pass = 1; (void)rep_pass; __VA_ARGS__ } } } SEAM(PH(p)); } while (0);

    unsigned char* ws = P.ws;
    bf16_t* WB = (bf16_t*)(ws + WS_WB);
    float* XF = (float*)(ws + WS_XF); float* PRE = (float*)(ws + WS_PRE); bf16_t* XB = (bf16_t*)(ws + WS_XB);
    bf16_t* BIG = (bf16_t*)(ws + WS_BIG);
    bf16_t* Ub = (bf16_t*)(ws + WS_BIG + BG_U); bf16_t* Pb = (bf16_t*)(ws + WS_BIG + BG_P); bf16_t* Gb = (bf16_t*)(ws + WS_BIG + BG_G); bf16_t* HID = (bf16_t*)(ws + WS_BIG + BG_HID);
    bf16_t* ATT = (bf16_t*)(ws + WS_AUX + AX_ATT); bf16_t* XP = (bf16_t*)(ws + WS_AUX + AX_XPERM); bf16_t* Yb = (bf16_t*)(ws + WS_AUX + AX_Y);
    const float* cosT = (const float*)(ws + WS_ROPE); const float* sinT = cosT + (size_t)M * 8;
    const float* ROWGATE = (const float*)(ws + WS_MISC + MS_ROWGATE); const int* OFFT = (const int*)(ws + WS_MISC + MS_OFF);
    const int bx = (int)blockIdx.x;

    PHASE(0, prologue_misc(C, P); convert_pool_ffn(C, P, 2); if (REP(32)) convert_pool_ffn(C, P, 2);)
    CHECK(0, chk_rope_xb(C, P, 0));

    PHASE(1, pg8::Gemm g{XB, WB + WB_MIX0, D, D, D}; pg8::StaticOrder S; S.init(M / 256, D / 256, C.G, bx); pg8::EpiBf16 E{Ub, D};
        pg8::gemm_phase<pg8::EpiBf16, pg8::StaticOrder>(C.lds, g, S, E);)
    CHECK(1, chk_gemm_bf16(C, P, 1, XB, D, P.in[2], D, D, Ub, D, D));
    PHASE(2, pool_phase(C, Ub, Pb);)
    CHECK(2, chk_pool(C, P, 2, Ub, Pb));
    PHASE(3, pg8::Gemm g{Pb, WB + WB_MIX1, D, 256, 256}; pg8::StaticOrder S; S.init(M / 256, 4, C.G, bx, 512u); pg8::EpiPre E{P.in[0], PRE, P.in[4]};
        pg8::gemm_phase<pg8::EpiPre, pg8::StaticOrder>(C.lds, g, S, E);)
    CHECK(3, chk_gemm_pre(C, P, 3, Pb, D, 256, 1, P.in[3], 256, P.in[0], P.in[4], PRE));
    PHASE(4, ln_phase<0, false>(C, P, PRE, nullptr, P.in[5], P.in[6], XF, XB, nullptr);)
    CHECK(4, chk_ln(C, P, 4, PRE, P.in[5], P.in[6], XF, XB));
    PHASE(5, pg8::Gemm g{XB, WB + WB_FFN0, D, D, D}; pg8::StaticOrder S; S.init(M / 256, 2 * FF / 256, C.G, bx); pg8::EpiSwiGLU E{HID, FF, (MK_DRY && rep_pass) ? P.step_lo : 0x7fffffff};
        pg8::gemm_phase<pg8::EpiSwiGLU, pg8::StaticOrder>(C.lds, g, S, E);)
    CHECK(5, chk_swiglu(C, P, 5, XB, P.in[7], P.in[8], HID));
    PHASE(6, pg8::Gemm g{HID, WB + WB_FFN1_DENSE, FF, FF, FF}; pg8::StaticOrder S; S.init(M / 256, D / 256, C.G, bx); pg8::EpiPre E{XF, PRE, nullptr};
        pg8::gemm_phase<pg8::EpiPre, pg8::StaticOrder>(C.lds, g, S, E);)
    CHECK(6, chk_gemm_pre(C, P, 6, HID, FF, FF, 0, P.in[9], D, XF, nullptr, PRE));
    PHASE(7, ln_phase<0, false>(C, P, PRE, nullptr, P.in[10], P.in[11], XF, XB, nullptr); __syncthreads(); convert_attn_moe(C, P, 12); if (REP(32)) convert_attn_moe(C, P, 12);)
    CHECK(7, chk_ln(C, P, 7, PRE, P.in[10], P.in[11], XF, XB));

    PHASE(8, pg8::Gemm g{XB, WB + WB_MIX0, D, D, D}; pg8::StaticOrder S; S.init(M / 256, QKVW / 256, C.G, bx); pg8::EpiQKV E{BIG, cosT, sinT};
        pg8::gemm_phase<pg8::EpiQKV, pg8::StaticOrder>(C.lds, g, S, E);)
    CHECK(8, chk_qkv(C, P, 8, XB, P.in[12], BIG));
    PHASE(9, attn_phase(C, P);)
    CHECK(9, chk_attn(C, P, 9));
    PHASE(10, combine_phase(C, P);)
    CHECK(10, chk_combine(C, P, 10));
    PHASE(11, pg8::Gemm g{ATT, WB + WB_MIX1, D, D, D}; pg8::StaticOrder S; S.init(M / 256, D / 256, C.G, bx); pg8::EpiPre E{XF, PRE, nullptr};
        pg8::gemm_phase<pg8::EpiPre, pg8::StaticOrder>(C.lds, g, S, E);)
    CHECK(11, chk_gemm_pre(C, P, 11, ATT, D, D, 0, P.in[13], D, XF, nullptr, PRE));
    PHASE(12, ln_phase<0, true>(C, P, PRE, nullptr, P.in[14], P.in[15], XF, XB, P.in[16]);)
    CHECK(12, { chk_ln(C, P, 12, PRE, P.in[14], P.in[15], XF, XB); chk_router(C, P, 12, XF, P.in[16]); });
    PHASE(13, moe_gather_phase(C, P);)
    CHECK(13, chk_gather(C, P, 13));
    PHASE(14, pg8::Gemm g{XP, WB + WB_FFN0, D, D, D}; pg8::MoeOrder S; S.so.init(OFFT[8] / 256, 2 * FFE / 256, C.G, bx);
        S.o1 = OFFT[1]; S.o2 = OFFT[2]; S.o3 = OFFT[3]; S.o4 = OFFT[4]; S.o5 = OFFT[5]; S.o6 = OFFT[6]; S.o7 = OFFT[7]; S.estride = 2u * FFE * D * 2u;
        pg8::EpiSwiGLU E{HID, FFE, (MK_DRY && rep_pass) ? P.step_lo : 0x7fffffff}; pg8::gemm_phase<pg8::EpiSwiGLU, pg8::MoeOrder>(C.lds, g, S, E);)
    CHECK(14, chk_moe_up(C, P, 14, P.in[17], P.in[18]));
    PHASE(15, pg8::Gemm g{HID, WB + WB_FFN1_MOE, FFE, FFE, FFE}; pg8::MoeOrder S; S.so.init(128, D / 256, C.G, bx);
        S.o1 = OFFT[1]; S.o2 = OFFT[2]; S.o3 = OFFT[3]; S.o4 = OFFT[4]; S.o5 = OFFT[5]; S.o6 = OFFT[6]; S.o7 = OFFT[7]; S.estride = (unsigned)D * FFE * 2u;
        pg8::EpiMoeDown E{Yb, ROWGATE}; pg8::gemm_phase<pg8::EpiMoeDown, pg8::MoeOrder>(C.lds, g, S, E);
        pg8::Gemm g2{HID, WB + WB_FFN1_MOE, FFE, FFE, 512}; pg8::MoeTailOrder T; T.nextra = OFFT[8] / 256 - 128; T.G = C.G; T.c = bx;
        T.o1 = S.o1; T.o2 = S.o2; T.o3 = S.o3; T.o4 = S.o4; T.o5 = S.o5; T.o6 = S.o6; T.o7 = S.o7; T.estride = S.estride;
        pg8::EpiMoeDownPart E2{(bf16_t*)(ws + WS_BIG + BG_YP), ROWGATE}; pg8::gemm_phase<pg8::EpiMoeDownPart, pg8::MoeTailOrder>(C.lds, g2, T, E2);)
    CHECK(15, chk_moe_down(C, P, 15, P.in[19]));
    PHASE(16, ln_phase<1, false>(C, P, nullptr, XF, P.in[20], P.in[21], PRE, XB, nullptr); __syncthreads(); convert_conv_ffn(C, P, 22); if (REP(32)) convert_conv_ffn(C, P, 22);)
    CHECK(16, chk_ln_moe(C, P, 16, XF, P.in[20], P.in[21], PRE, XB));

    PHASE(17, pg8::Gemm g{XB, WB + WB_MIX0, D, D, D}; pg8::StaticOrder S; S.init(M / 256, 3 * D / 256, C.G, bx); pg8::EpiConvIn E{Ub, Pb};
        pg8::gemm_phase<pg8::EpiConvIn, pg8::StaticOrder>(C.lds, g, S, E);)
    CHECK(17, chk_convin(C, P, 17, XB, P.in[22], Ub, Pb));
    PHASE(18, conv_phase(C, Ub, Pb, P.in[23], Gb);)
    CHECK(18, chk_conv(C, P, 18, Ub, Pb, P.in[23], Gb));
    PHASE(19, pg8::Gemm g{Gb, WB + WB_MIX1, D, D, D}; pg8::StaticOrder S; S.init(M / 256, D / 256, C.G, bx); pg8::EpiPre E{PRE, XF, nullptr};
        pg8::gemm_phase<pg8::EpiPre, pg8::StaticOrder>(C.lds, g, S, E);)
    CHECK(19, chk_gemm_pre(C, P, 19, Gb, D, D, 0, P.in[24], D, PRE, nullptr, XF));
    PHASE(20, ln_phase<0, false>(C, P, XF, nullptr, P.in[25], P.in[26], PRE, XB, nullptr);)
    CHECK(20, chk_ln(C, P, 20, XF, P.in[25], P.in[26], PRE, XB));
    PHASE(21, pg8::Gemm g{XB, WB + WB_FFN0, D, D, D}; pg8::StaticOrder S; S.init(M / 256, 2 * FF / 256, C.G, bx); pg8::EpiSwiGLU E{HID, FF, (MK_DRY && rep_pass) ? P.step_lo : 0x7fffffff};
        pg8::gemm_phase<pg8::EpiSwiGLU, pg8::StaticOrder>(C.lds, g, S, E);)
    CHECK(21, chk_swiglu(C, P, 21, XB, P.in[27], P.in[28], HID));
    PHASE(22, pg8::Gemm g{HID, WB + WB_FFN1_DENSE, FF, FF, FF}; pg8::StaticOrder S; S.init(M / 256, D / 256, C.G, bx); pg8::EpiPre E{PRE, XF, nullptr};
        pg8::gemm_phase<pg8::EpiPre, pg8::StaticOrder>(C.lds, g, S, E);)
    CHECK(22, chk_gemm_pre(C, P, 22, HID, FF, FF, 0, P.in[29], D, PRE, nullptr, XF));
    PHASE(23, ln_phase<0, false>(C, P, XF, nullptr, P.in[30], P.in[31], PRE, XB, nullptr); __syncthreads(); convert_pool_moe(C, P, 32); if (REP(32)) convert_pool_moe(C, P, 32);)
    CHECK(23, chk_ln(C, P, 23, XF, P.in[30], P.in[31], PRE, XB));

    PHASE(24, pg8::Gemm g{XB, WB + WB_MIX0, D, D, D}; pg8::StaticOrder S; S.init(M / 256, D / 256, C.G, bx); pg8::EpiBf16 E{Ub, D};
        pg8::gemm_phase<pg8::EpiBf16, pg8::StaticOrder>(C.lds, g, S, E);)
    CHECK(24, chk_gemm_bf16(C, P, 24, XB, D, P.in[32], D, D, Ub, D, D));
    PHASE(25, pool_phase(C, Ub, Pb);)
    CHECK(25, chk_pool(C, P, 25, Ub, Pb));
    PHASE(26, pg8::Gemm g{Pb, WB + WB_MIX1, D, 256, 256}; pg8::StaticOrder S; S.init(M / 256, 4, C.G, bx, 512u); pg8::EpiPre E{PRE, XF, P.in[34]};
        pg8::gemm_phase<pg8::EpiPre, pg8::StaticOrder>(C.lds, g, S, E);)
    CHECK(26, chk_gemm_pre(C, P, 26, Pb, D, 256, 1, P.in[33], 256, PRE, P.in[34], XF));
    PHASE(27, ln_phase<0, true>(C, P, XF, nullptr, P.in[35], P.in[36], PRE, XB, P.in[37]);)
    CHECK(27, { chk_ln(C, P, 27, XF, P.in[35], P.in[36], PRE, XB); chk_router(C, P, 27, PRE, P.in[37]); });
    PHASE(28, moe_gather_phase(C, P);)
    CHECK(28, chk_gather(C, P, 28));
    PHASE(29, pg8::Gemm g{XP, WB + WB_FFN0, D, D, D}; pg8::MoeOrder S; S.so.init(OFFT[8] / 256, 2 * FFE / 256, C.G, bx);
        S.o1 = OFFT[1]; S.o2 = OFFT[2]; S.o3 = OFFT[3]; S.o4 = OFFT[4]; S.o5 = OFFT[5]; S.o6 = OFFT[6]; S.o7 = OFFT[7]; S.estride = 2u * FFE * D * 2u;
        pg8::EpiSwiGLU E{HID, FFE, (MK_DRY && rep_pass) ? P.step_lo : 0x7fffffff}; pg8::gemm_phase<pg8::EpiSwiGLU, pg8::MoeOrder>(C.lds, g, S, E);)
    CHECK(29, chk_moe_up(C, P, 29, P.in[38], P.in[39]));
    PHASE(30, pg8::Gemm g{HID, WB + WB_FFN1_MOE, FFE, FFE, FFE}; pg8::MoeOrder S; S.so.init(128, D / 256, C.G, bx);
        S.o1 = OFFT[1]; S.o2 = OFFT[2]; S.o3 = OFFT[3]; S.o4 = OFFT[4]; S.o5 = OFFT[5]; S.o6 = OFFT[6]; S.o7 = OFFT[7]; S.estride = (unsigned)D * FFE * 2u;
        pg8::EpiMoeDown E{Yb, ROWGATE}; pg8::gemm_phase<pg8::EpiMoeDown, pg8::MoeOrder>(C.lds, g, S, E);
        pg8::Gemm g2{HID, WB + WB_FFN1_MOE, FFE, FFE, 512}; pg8::MoeTailOrder T; T.nextra = OFFT[8] / 256 - 128; T.G = C.G; T.c = bx;
        T.o1 = S.o1; T.o2 = S.o2; T.o3 = S.o3; T.o4 = S.o4; T.o5 = S.o5; T.o6 = S.o6; T.o7 = S.o7; T.estride = S.estride;
        pg8::EpiMoeDownPart E2{(bf16_t*)(ws + WS_BIG + BG_YP), ROWGATE}; pg8::gemm_phase<pg8::EpiMoeDownPart, pg8::MoeTailOrder>(C.lds, g2, T, E2);)
    CHECK(30, chk_moe_down(C, P, 30, P.in[40]));
    PHASE(31, ln_phase<1, false>(C, P, nullptr, PRE, P.in[41], P.in[42], P.out, nullptr, nullptr);)
    CHECK(31, chk_ln_moe(C, P, 31, PRE, P.in[41], P.in[42], P.out, nullptr));
#if MK_CHECK
    if (IN(2 * NPHASE)) {
        const float* ck = (const float*)ctl + CW_CHK; int bad = -1;
        for (int p = 0; p < NPHASE; ++p) { const float e2 = __hip_atomic_load(ck + 2 * p, __ATOMIC_RELAXED, __HIP_MEMORY_SCOPE_AGENT), r2 = __hip_atomic_load(ck + 2 * p + 1, __ATOMIC_RELAXED, __HIP_MEMORY_SCOPE_AGENT); if (bad < 0 && !(e2 <= 2e-4f * r2)) bad = p; }
        float code = bad >= 0 ? (float)(10 + 2 * bad) : 0.f;
        if (__hip_atomic_load(ctl + CW_BAR + XB_TMO, __ATOMIC_RELAXED, __HIP_MEMORY_SCOPE_AGENT) != 0u || __hip_atomic_load(ctl + 1, __ATOMIC_RELAXED, __HIP_MEMORY_SCOPE_AGENT) != 0u) code = 98.f;
        if (code > 0.f) { const float v = sqrtf(code - 1.f); for (int i = C.bid * 512 + C.tid; i < M * D; i += C.G * 512) P.out[i] = v; }
    }
#endif
#undef IN
#undef SEAM
#undef CHECK
#undef PH
#undef REP
#undef PHASE
}

extern "C" void kernel_launch(void* const* d_in, const int* in_sizes, int n_in, void* d_out, int out_size, void* d_ws, size_t ws_size, hipStream_t stream) {
    static int grid = 0;
    if (grid == 0) {
        if (n_in != 43 || in_sizes[0] != M * D || out_size != M * D || ws_size < WS_END) { fprintf(stderr, "kernel_launch: unexpected shapes (n_in %d, in0 %d, out %d, ws %zu)\n", n_in, n_in > 0 ? in_sizes[0] : -1, out_size, ws_size); grid = -1; return; }
        int dev = 0, cus = 0, per_cu = 0;
        if (hipGetDevice(&dev) != hipSuccess || hipDeviceGetAttribute(&cus, hipDeviceAttributeMultiprocessorCount, dev) != hipSuccess) { grid = -1; return; }
        if (hipFuncSetAttribute((const void*)hybrid_fwd, hipFuncAttributeMaxDynamicSharedMemorySize, LDS_BYTES) != hipSuccess) { fprintf(stderr, "kernel_launch: hipFuncSetAttribute failed\n"); grid = -1; return; }
        if (hipOccupancyMaxActiveBlocksPerMultiprocessor(&per_cu, (const void*)hybrid_fwd, NWAVES * 64, LDS_BYTES) != hipSuccess || per_cu < 1) { fprintf(stderr, "kernel_launch: occupancy query says %d\n", per_cu); }
        (void)hipGetLastError();
        grid = cus;
        if (grid != 256) { fprintf(stderr, "kernel_launch: built for 256 CUs, device has %d\n", cus); grid = -1; return; }
    }
    if (grid < 0) return;
    (void)hipMemsetAsync((char*)d_ws + WS_CTL, 0, CTL_ZERO_BYTES, stream);
    Params p{};
    for (int i = 0; i < 43; ++i) p.in[i] = (const float*)d_in[i];
    p.positions = (const int*)d_in[1]; p.out = (float*)d_out; p.ws = (unsigned char*)d_ws;
#if MK_PER_PHASE
    for (int s = 0; s < NSTEPS; ++s) { p.step_lo = s; p.step_hi = s + 1; hipLaunchKernelGGL(hybrid_fwd, dim3(grid), dim3(NWAVES * 64), LDS_BYTES, stream, p); }
#else
    p.step_lo = 0; p.step_hi = NSTEPS;
    hipLaunchKernelGGL(hybrid_fwd, dim3(grid), dim3(NWAVES * 64), LDS_BYTES, stream, p);
#endif
}
```
